# Optimizing an MI355X kernel written in HIP

```python
import math
import jax
import jax.numpy as jnp
from jax import lax
import numpy as np

D_MODEL = 1024
BATCH = 4
SEQ = 8192
DEPTH = 4

GRID_W = 64
CTX_LEN = 256
N_MIXERS = 3
EPS = 1e-6
ROPE_BASE = 10000.0
Q_BLOCK = 128
N_MOD = 6

MLA_HEADS = 8
MLA_NOPE = 128
MLA_ROPE = 64
MLA_V = 128
MLA_Q_RANK = 384
MLA_KV_RANK = 256

HG_HEADS = 8
HG_DK = D_MODEL // HG_HEADS
HG_DV = D_MODEL // HG_HEADS
HG_CHUNK = 64

DF_HEADS = 8
DF_DQK = D_MODEL // (2 * DF_HEADS)
DF_DV = 2 * DF_DQK

D_FF = -(-(8 * D_MODEL) // (3 * 256)) * 256

N_MLA = (DEPTH + N_MIXERS - 1) // N_MIXERS
N_HG = (DEPTH + N_MIXERS - 2) // N_MIXERS
N_DF = DEPTH // N_MIXERS

kernel_name = 'hybrid_mla_hgrn2_diffattn_dit'


def rms_norm(x, w):
    xf = x.astype(jnp.float32)
    y = xf * lax.rsqrt(jnp.mean(xf * xf, axis=-1, keepdims=True) + EPS)
    return (y * w.astype(jnp.float32)).astype(x.dtype)


def modulate(x, shift, scale):
    return x * (1 + scale) + shift


def swiglu(a, w1, w3, w2):
    return (jax.nn.silu(a @ w1) * (a @ w3)) @ w2


def split_heads(t, n_heads):
    b, n, _ = t.shape
    return t.reshape(b, n, n_heads, -1).transpose(0, 2, 1, 3)


def merge_heads(t):
    b, h, n, d = t.shape
    return t.transpose(0, 2, 1, 3).reshape(b, n, h * d)


def axial_rope_tables(rows, rot_dim):
    row = jnp.repeat(jnp.arange(rows, dtype=jnp.float32), GRID_W)
    col = jnp.tile(jnp.arange(GRID_W, dtype=jnp.float32), rows)
    axis_dim = rot_dim // 2
    inv_freq = jnp.power(ROPE_BASE, -jnp.arange(0, axis_dim, 2, dtype=jnp.float32) / axis_dim)
    ang_r = row[:, None] * inv_freq
    ang_c = col[:, None] * inv_freq
    ang = jnp.concatenate([ang_r, ang_r, ang_c, ang_c], axis=-1)
    return jnp.cos(ang), jnp.sin(ang)


def apply_axial_rope(t, cos, sin):
    t1, t2, t3, t4 = jnp.split(t, 4, axis=-1)
    rot = jnp.concatenate([-t2, t1, -t4, t3], axis=-1)
    return (t * cos + rot * sin).astype(t.dtype)


def softmax_attend(q, k, v, scale):
    s = jnp.einsum('bhqd,bhkd->bhqk', q, k, preferred_element_type=jnp.float32) * scale
    p = jax.nn.softmax(s, axis=-1)
    return jnp.einsum('bhqk,bhkd->bhqd', p.astype(v.dtype), v)


def sweep_query_blocks(fn, q):
    n, d = q.shape[-2], q.shape[-1]
    nb = n // Q_BLOCK
    qb = jnp.moveaxis(q.reshape(q.shape[:-2] + (nb, Q_BLOCK, d)), -3, 0)
    o = jnp.moveaxis(lax.map(fn, qb), 0, -3)
    return o.reshape(o.shape[:-3] + (n, o.shape[-1]))


def gla_chunk_scan(q, k, v, log_f, s0):
    b, h, n, _ = q.shape
    nc = n // HG_CHUNK

    def chunks(t):
        return jnp.moveaxis(t.reshape(b, h, nc, HG_CHUNK, t.shape[-1]), 2, 0)

    order = jnp.tril(jnp.ones((HG_CHUNK, HG_CHUNK), dtype=bool))[:, :, None]

    def step(state, inp):
        qc, kc, vc, lfc = inp
        cum = jnp.cumsum(lfc, axis=-2)
        rel = jnp.where(order, cum[..., :, None, :] - cum[..., None, :, :], -jnp.inf)
        att = jnp.einsum('bhtd,bhsd,bhtsd->bhts', qc, kc, jnp.exp(rel))
        o = (jnp.einsum('bhts,bhse->bhte', att, vc)
             + jnp.einsum('bhtd,bhde->bhte', qc * jnp.exp(cum), state))
        last = cum[..., -1:, :]
        state = (jnp.exp(last[..., 0, :])[..., None] * state
                 + jnp.einsum('bhsd,bhse->bhde', kc * jnp.exp(last - cum), vc))
        return state, o

    state, o = lax.scan(step, s0, (chunks(q), chunks(k), chunks(v), chunks(log_f)))
    o = jnp.moveaxis(o, 0, 2).reshape(b, h, n, v.shape[-1])
    return o, state


def mla_mixer(a_lat, a_ctx, rope, w_in, q_norm_w, kv_norm_w, w_uq, w_ukv, qn_w, qr_w, kn_w, kr_w, w_o, update_ctx):
    cos, sin = rope

    def project(a):
        b, n, _ = a.shape
        cq, ckv, kr = jnp.split(a @ w_in, [MLA_Q_RANK, MLA_Q_RANK + MLA_KV_RANK], axis=-1)
        q = split_heads(rms_norm(cq, q_norm_w) @ w_uq, MLA_HEADS)
        kv = split_heads(rms_norm(ckv, kv_norm_w) @ w_ukv, MLA_HEADS)
        q_nope = rms_norm(q[..., :MLA_NOPE], qn_w)
        q_rope = rms_norm(q[..., MLA_NOPE:], qr_w)
        k_nope = rms_norm(kv[..., :MLA_NOPE], kn_w)
        v = kv[..., MLA_NOPE:]
        k_rope = rms_norm(kr, kr_w)[:, None]
        return q_nope, q_rope, k_nope, k_rope, v

    def full_k(kn, kr):
        return jnp.concatenate([kn, jnp.broadcast_to(kr, kn.shape[:-1] + (MLA_ROPE,))], axis=-1)

    qn_l, qr_l, kn_l, kr_l, v_l = project(a_lat)
    qr_l = apply_axial_rope(qr_l, cos, sin)
    kr_l = apply_axial_rope(kr_l, cos, sin)
    qn_c, qr_c, kn_c, kr_c, v_c = project(a_ctx)
    k_c = full_k(kn_c, kr_c)
    k_all = jnp.concatenate([k_c, full_k(kn_l, kr_l)], axis=-2)
    v_all = jnp.concatenate([v_c, v_l], axis=-2)
    scale = 1.0 / math.sqrt(MLA_NOPE + MLA_ROPE)
    q_l = jnp.concatenate([qn_l, qr_l], axis=-1)
    o_l = sweep_query_blocks(lambda qb: softmax_attend(qb, k_all, v_all, scale), q_l)
    out_l = merge_heads(o_l) @ w_o
    out_c = None
    if update_ctx:
        q_c = jnp.concatenate([qn_c, qr_c], axis=-1)
        out_c = merge_heads(softmax_attend(q_c, k_c, v_c, scale)) @ w_o
    return out_l, out_c


def hgrn2_mixer(a_lat, a_ctx, layer_idx, w_in, lb_logits, o_norm_w, w_o, update_ctx):
    lb_cum = jnp.cumsum(jax.nn.softmax(lb_logits.astype(jnp.float32), axis=0), axis=0)
    lb = lb_cum[layer_idx] - lb_cum[0]

    def project(a):
        q, zf, zb, i, g = jnp.split(a @ w_in, 5, axis=-1)

        def heads(t):
            return split_heads(t, HG_HEADS).astype(jnp.float32)

        def log_forget(z, lbd):
            lbd = lbd.reshape(HG_HEADS, 1, HG_DK)
            return jnp.logaddexp(jnp.log(lbd), jnp.log1p(-lbd) + jax.nn.log_sigmoid(heads(z)))

        return heads(q), heads(i), log_forget(zf, lb[0]), log_forget(zb, lb[1]), g

    def scan_dir(q, i, log_f, s0):
        return gla_chunk_scan(q, -jnp.expm1(log_f), i, log_f, s0)

    def rev(t):
        return jnp.flip(t, axis=-2)

    def readout(o, g):
        o = rms_norm(o.astype(a_lat.dtype), o_norm_w)
        return (merge_heads(o) * jax.nn.silu(g)) @ w_o

    q_l, i_l, lf_l, lbk_l, g_l = project(a_lat)
    q_c, i_c, lf_c, lbk_c, g_c = project(a_ctx)
    s0 = jnp.zeros((a_ctx.shape[0], HG_HEADS, HG_DK, HG_DV), jnp.float32)
    o_cf, s_cf = scan_dir(q_c, i_c, lf_c, s0)
    o_cb, s_cb = scan_dir(rev(q_c), rev(i_c), rev(lbk_c), s0)
    o_lf, _ = scan_dir(q_l, i_l, lf_l, s_cf)
    o_lb, _ = scan_dir(rev(q_l), rev(i_l), rev(lbk_l), s_cb)
    out_l = readout(o_lf + rev(o_lb), g_l)
    out_c = readout(o_cf + rev(o_cb), g_c) if update_ctx else None
    return out_l, out_c


def diff_mixer(a_lat, a_ctx, rope, layer_idx, w_qkv, qn_w, kn_w, lam_vec, sub_norm_w, w_o, update_ctx):
    cos, sin = rope
    lam_init = 0.8 - 0.6 * math.exp(-0.3 * layer_idx)
    lv = lam_vec.astype(jnp.float32)
    lam = jnp.exp(jnp.sum(lv[0] * lv[1])) - jnp.exp(jnp.sum(lv[2] * lv[3])) + lam_init

    def project(a):
        b, n, _ = a.shape
        q, k, v = jnp.split(a @ w_qkv, 3, axis=-1)
        q = rms_norm(q.reshape(b, n, DF_HEADS, 2, DF_DQK).transpose(0, 2, 3, 1, 4), qn_w)
        k = rms_norm(k.reshape(b, n, DF_HEADS, 2, DF_DQK).transpose(0, 2, 3, 1, 4), kn_w)
        return q, k, split_heads(v, DF_HEADS)

    scale = 1.0 / math.sqrt(DF_DQK)

    def diff_attend(q, k, v):
        s = jnp.einsum('bhmqd,bhmkd->bhmqk', q, k, preferred_element_type=jnp.float32) * scale
        p = jax.nn.softmax(s, axis=-1)
        a = p[:, :, 0] - lam * p[:, :, 1]
        return jnp.einsum('bhqk,bhkd->bhqd', a.astype(v.dtype), v)

    def readout(o):
        return merge_heads(rms_norm(o, sub_norm_w) * (1.0 - lam_init)) @ w_o

    q_l, k_l, v_l = project(a_lat)
    q_l = apply_axial_rope(q_l, cos, sin)
    k_l = apply_axial_rope(k_l, cos, sin)
    q_c, k_c, v_c = project(a_ctx)
    k_all = jnp.concatenate([k_c, k_l], axis=-2)
    v_all = jnp.concatenate([v_c, v_l], axis=-2)
    out_l = readout(sweep_query_blocks(lambda qb: diff_attend(qb, k_all, v_all), q_l))
    out_c = readout(diff_attend(q_c, k_c, v_c)) if update_ctx else None
    return out_l, out_c


def setup_inputs(seed: int = 0) -> dict:
    key = jax.random.key(seed)
    ks = iter(jax.random.split(key, 40))
    D = D_MODEL

    def nrm(shape, scale):
        return scale * jax.random.normal(next(ks), shape, jnp.float32)

    def gain(shape):
        return 1.0 + nrm(shape, 0.02)

    return {
        'x': nrm((BATCH, SEQ, D), 1.0),
        'c': nrm((BATCH, D), 1.0),
        'ctx': nrm((BATCH, CTX_LEN, D), 1.0),
        'c_ctx': nrm((D,), 1.0),
        'ada_w': nrm((DEPTH, D, N_MOD * D), 0.5 * D ** -0.5),
        'ada_b': nrm((DEPTH, N_MOD * D), 0.02),
        'norm1_w': gain((DEPTH, D)),
        'norm2_w': gain((DEPTH, D)),
        'ffn_w1': nrm((DEPTH, D, D_FF), D ** -0.5),
        'ffn_w3': nrm((DEPTH, D, D_FF), D ** -0.5),
        'ffn_w2': nrm((DEPTH, D_FF, D), D_FF ** -0.5),
        'mla_w_in': nrm((N_MLA, D, MLA_Q_RANK + MLA_KV_RANK + MLA_ROPE), D ** -0.5),
        'mla_q_norm_w': gain((N_MLA, MLA_Q_RANK)),
        'mla_kv_norm_w': gain((N_MLA, MLA_KV_RANK)),
        'mla_w_uq': nrm((N_MLA, MLA_Q_RANK, MLA_HEADS * (MLA_NOPE + MLA_ROPE)), MLA_Q_RANK ** -0.5),
        'mla_w_ukv': nrm((N_MLA, MLA_KV_RANK, MLA_HEADS * (MLA_NOPE + MLA_V)), MLA_KV_RANK ** -0.5),
        'mla_qn_w': gain((N_MLA, MLA_NOPE)),
        'mla_qr_w': gain((N_MLA, MLA_ROPE)),
        'mla_kn_w': gain((N_MLA, MLA_NOPE)),
        'mla_kr_w': gain((N_MLA, MLA_ROPE)),
        'mla_w_o': nrm((N_MLA, MLA_HEADS * MLA_V, D), (MLA_HEADS * MLA_V) ** -0.5),
        'hg_w_in': nrm((N_HG, D, 5 * D), D ** -0.5),
        'hg_lb_logits': nrm((DEPTH, 2, D), 1.0),
        'hg_o_norm_w': gain((N_HG, HG_DV)),
        'hg_w_o': nrm((N_HG, D, D), D ** -0.5),
        'df_w_qkv': nrm((N_DF, D, 3 * D), D ** -0.5),
        'df_qn_w': gain((N_DF, DF_DQK)),
        'df_kn_w': gain((N_DF, DF_DQK)),
        'df_lambda': nrm((N_DF, 4, DF_DQK), 0.1),
        'df_sub_norm_w': gain((N_DF, DF_DV)),
        'df_w_o': nrm((N_DF, D, D), D ** -0.5),
    }


def reference(x, c, ctx, c_ctx, ada_w, ada_b, norm1_w, norm2_w, ffn_w1, ffn_w3, ffn_w2,
              mla_w_in, mla_q_norm_w, mla_kv_norm_w, mla_w_uq, mla_w_ukv, mla_qn_w, mla_qr_w, mla_kn_w,
              mla_kr_w, mla_w_o, hg_w_in, hg_lb_logits, hg_o_norm_w, hg_w_o,
              df_w_qkv, df_qn_w, df_kn_w, df_lambda, df_sub_norm_w, df_w_o):
    rows = x.shape[1] // GRID_W
    rope_mla = axial_rope_tables(rows, MLA_ROPE)
    rope_df = axial_rope_tables(rows, DF_DQK)
    h_ctx = ctx
    for i in range(DEPTH):
        kind, j = i % N_MIXERS, i // N_MIXERS
        update_ctx = i < DEPTH - 1
        mod_l = jnp.split((jax.nn.silu(c) @ ada_w[i] + ada_b[i])[:, None, :], N_MOD, axis=-1)
        mod_c = jnp.split((jax.nn.silu(c_ctx) @ ada_w[i] + ada_b[i])[None, None, :], N_MOD, axis=-1)
        a_l = modulate(rms_norm(x, norm1_w[i]), mod_l[0], mod_l[1])
        a_c = modulate(rms_norm(h_ctx, norm1_w[i]), mod_c[0], mod_c[1])
        if kind == 0:
            o_l, o_c = mla_mixer(a_l, a_c, rope_mla, mla_w_in[j], mla_q_norm_w[j], mla_kv_norm_w[j],
                                 mla_w_uq[j], mla_w_ukv[j], mla_qn_w[j], mla_qr_w[j], mla_kn_w[j],
                                 mla_kr_w[j], mla_w_o[j], update_ctx)
        elif kind == 1:
            o_l, o_c = hgrn2_mixer(a_l, a_c, i, hg_w_in[j], hg_lb_logits, hg_o_norm_w[j], hg_w_o[j], update_ctx)
        else:
            o_l, o_c = diff_mixer(a_l, a_c, rope_df, i, df_w_qkv[j], df_qn_w[j], df_kn_w[j], df_lambda[j],
                                  df_sub_norm_w[j], df_w_o[j], update_ctx)
        x = x + mod_l[2] * o_l
        x = x + mod_l[5] * swiglu(modulate(rms_norm(x, norm2_w[i]), mod_l[3], mod_l[4]),
                                  ffn_w1[i], ffn_w3[i], ffn_w2[i])
        if update_ctx:
            h_ctx = h_ctx + mod_c[2] * o_c
            h_ctx = h_ctx + mod_c[5] * swiglu(modulate(rms_norm(h_ctx, norm2_w[i]), mod_c[3], mod_c[4]),
                                              ffn_w1[i], ffn_w3[i], ffn_w2[i])
    return x
```

```cpp
#include <hip/hip_runtime.h>
#include <hip/hip_cooperative_groups.h>
#include <cstdio>
namespace cg = cooperative_groups;

#define DI __device__ __forceinline__
#define PIN() do { asm volatile("" ::: "memory"); __builtin_amdgcn_sched_barrier(0); } while (0)
#ifndef MULTI_LAUNCH
#define MULTI_LAUNCH 0
#endif
#define PROBE_ON 0
#define PROBE_SEL(ph) (((ph) - 1) % 9 == 1 || (ph) == 4 || (ph) == 31 || ((ph) - 1) % 9 == 5 || ((ph) - 1) % 9 == 7 || ((ph) - 1) % 9 == 8)

typedef unsigned short bf16_t;
using bf16x8 = __attribute__((ext_vector_type(8))) short;
using f32x16 = __attribute__((ext_vector_type(16))) float;
#define MFMA(a, b, c) __builtin_amdgcn_mfma_f32_32x32x16_bf16((a), (b), (c), 0, 0, 0)

constexpr int NB = 4, SEQ = 8192, CTXL = 256, PL = 8448, NT = NB * PL, DM = 1024, DFF = 2816;
constexpr int MT = NT / 256;
constexpr int PT = PL / 256;
constexpr int NTHR = 512;
constexpr float EPS = 1e-6f;

constexpr size_t OFF_W13 = 0;
constexpr size_t OFF_W2 = 11534336;
constexpr size_t OFF_MIX = 17301504;
constexpr size_t OFF_MODS = 33554432;
constexpr size_t OFF_LB = OFF_MODS + 524288;
constexpr size_t OFF_LAM = OFF_MODS + 540672;
constexpr size_t OFF_COS = OFF_MODS + 544768;
constexpr size_t OFF_SIN = OFF_MODS + 552960;
constexpr size_t OFF_BAR = OFF_MODS + 589824;
constexpr size_t OFF_CTXX = 34603008;
constexpr size_t OFF_ABUF = 38797312;
constexpr size_t OFF_SCR = 108003328;
constexpr size_t ACT16 = (size_t)NT * DM * 2;
constexpr size_t WS_NEED = OFF_SCR + 6 * ACT16;
constexpr size_t MLA_Q = OFF_SCR;
constexpr size_t MLA_K = MLA_Q + (size_t)NT * 8 * 192 * 2;
constexpr size_t MLA_VT = MLA_K + (size_t)NT * 8 * 192 * 2;
constexpr size_t MLA_CQN = MLA_VT + ACT16;
constexpr size_t MLA_CKVN = MLA_CQN + (size_t)NT * 384 * 2;
constexpr size_t HG_Q = OFF_SCR, HG_KF = HG_Q + ACT16, HG_KB = HG_KF + ACT16, HG_I = HG_KB + ACT16, HG_G = HG_I + ACT16, HG_OB = HG_G + ACT16;
constexpr size_t DF_Q = OFF_SCR, DF_K = DF_Q + ACT16, DF_VT = DF_K + ACT16;
constexpr size_t FFN_H = OFF_SCR;

constexpr int LDS_PHASE = 147456;
constexpr int LDS_BYTES = LDS_PHASE + 16;

struct Params {
  const float* in[31];
  float* out;
  char* ws;
  int ph_lo, ph_hi;
};

DI int TID() { int t = threadIdx.x; asm volatile("" : "+v"(t)); return t; }
DI int BID() { int t = blockIdx.x; asm volatile("" : "+s"(t)); return t; }
DI float bf2f(unsigned short v) { return __uint_as_float(((unsigned)v) << 16); }
typedef float f32x2_t __attribute__((ext_vector_type(2)));
typedef __bf16 bf16x2_t __attribute__((ext_vector_type(2)));
DI unsigned pk2(float a, float b) { f32x2_t v = {a, b}; bf16x2_t r = __builtin_convertvector(v, bf16x2_t); return __builtin_bit_cast(unsigned, r); }
DI unsigned short f2bf(float x) { return (unsigned short)(pk2(x, 0.f) & 0xffffu); }
DI float sigmf(float x) { return __builtin_amdgcn_rcpf(1.f + __builtin_amdgcn_exp2f(-1.4426950408889634f * x)); }
DI float siluf(float x) { return x * sigmf(x); }
DI int crow(int i, int h) { return (i & 3) + 8 * (i >> 2) + 4 * h; }
DI float wave_sum(float v) {
#pragma unroll
  for (int o = 32; o > 0; o >>= 1) v += __shfl_xor(v, o);
  return v;
}
DI float* xrow(const Params& p, int r) {
  int b = r / PL, pp = r - b * PL;
  return pp < CTXL ? (float*)(p.ws + OFF_CTXX) + (size_t)(b * CTXL + pp) * DM : p.out + (size_t)(b * SEQ + pp - CTXL) * DM;
}

DI void phase0(const Params& p, char* smem) {
  const int tid = TID(), lane = tid & 63, wv = tid >> 6;
  const size_t gsz = (size_t)gridDim.x * NTHR, gid = (size_t)BID() * NTHR + tid;
  {
    const float4* xs = (const float4*)p.in[0]; float4* xd = (float4*)p.out;
    for (size_t i = gid; i < (size_t)NB * SEQ * DM / 4; i += gsz) xd[i] = xs[i];
    const float4* cs = (const float4*)p.in[2]; float4* cd = (float4*)(p.ws + OFF_CTXX);
    for (size_t i = gid; i < (size_t)NB * CTXL * DM / 4; i += gsz) cd[i] = cs[i];
  }
  if (gid < 2048) {
    int pos = (int)gid >> 4, j = (int)gid & 15;
    float invf = powf(10000.f, -(float)(2 * j) / 32.f);
    float ang = (float)pos * invf;
    ((float*)(p.ws + OFF_COS))[gid] = cosf(ang);
    ((float*)(p.ws + OFF_SIN))[gid] = sinf(ang);
  }
  if (gid >= 2048 && gid < 4096) {
    int d = (int)gid - 2048;
    const float* lg = p.in[22];
    float l0 = lg[d], l1 = lg[2048 + d], l2 = lg[4096 + d], l3 = lg[6144 + d];
    float mx = fmaxf(fmaxf(l0, l1), fmaxf(l2, l3));
    float e0 = expf(l0 - mx), e1 = expf(l1 - mx), e2 = expf(l2 - mx), e3 = expf(l3 - mx);
    ((float*)(p.ws + OFF_LB))[d] = e1 / (e0 + e1 + e2 + e3);
  }
  if (gid == 4096) {
    const float* lv = p.in[28];
    float s01 = 0.f, s23 = 0.f;
    for (int j = 0; j < 64; ++j) { s01 += lv[j] * lv[64 + j]; s23 += lv[128 + j] * lv[192 + j]; }
    float lam_init = 0.8f - 0.6f * expf(-0.3f * 2.f);
    ((float*)(p.ws + OFF_LAM))[0] = expf(s01) - expf(s23) + lam_init;
  }
  float* sS = (float*)smem;
  float* red = sS + 5 * 1024;
  for (int i = tid; i < 5 * 1024; i += NTHR) {
    int r = i >> 10, k = i & 1023;
    float c = r < 4 ? p.in[1][r * 1024 + k] : p.in[3][k];
    sS[i] = siluf(c);
  }
  __syncthreads();
  float* mods = (float*)(p.ws + OFF_MODS);
  for (int job = BID(); job < 4 * 96; job += gridDim.x) {
    int li = job / 96, cgp = job % 96, n = cgp * 64 + lane;
    const float* W = p.in[4] + ((size_t)li * 1024 + wv * 128) * 6144 + n;
    float a0 = 0, a1 = 0, a2 = 0, a3 = 0, a4 = 0;
#pragma unroll 4
    for (int k = 0; k < 128; ++k) {
      float w = W[(size_t)k * 6144];
      int kk = wv * 128 + k;
      a0 += sS[kk] * w; a1 += sS[1024 + kk] * w; a2 += sS[2048 + kk] * w; a3 += sS[3072 + kk] * w; a4 += sS[4096 + kk] * w;
    }
    red[(wv * 5 + 0) * 64 + lane] = a0; red[(wv * 5 + 1) * 64 + lane] = a1; red[(wv * 5 + 2) * 64 + lane] = a2;
    red[(wv * 5 + 3) * 64 + lane] = a3; red[(wv * 5 + 4) * 64 + lane] = a4;
    __syncthreads();
    if (tid < 320) {
      int r = tid >> 6, l = tid & 63;
      float s = 0.f;
#pragma unroll
      for (int w = 0; w < 8; ++w) s += red[(w * 5 + r) * 64 + l];
      int nn = cgp * 64 + l;
      mods[(size_t)(li * 5 + r) * 6144 + nn] = s + p.in[5][li * 6144 + nn];
    }
    __syncthreads();
  }
}

DI void convert_w(const float* src, const float* src2, int srcN, int K, bf16_t* dst, int Nd, int mode) {
  const size_t gsz = (size_t)gridDim.x * NTHR, gid = (size_t)BID() * NTHR + TID();
  const size_t total = (size_t)Nd * (K >> 3);
  for (size_t e = gid; e < total; e += gsz) {
    int nd = (int)(e % Nd), k0 = (int)(e / Nd) * 8;
    const float* s = src; int col = nd; bool valid = true;
    if (mode == 0) { valid = nd < srcN; }
    else if (mode == 1) { int g = nd >> 6, w = nd & 63; if (w < 32) col = g * 32 + w; else { s = src2; col = g * 32 + w - 32; } }
    else { if (nd < 1024) col = (nd >> 7) * 192 + (nd & 127); else { int r = nd - 1024; col = (r >> 6) * 192 + 128 + (r & 63); } }
    float v[8];
#pragma unroll
    for (int j = 0; j < 8; ++j) v[j] = valid ? s[(size_t)(k0 + j) * srcN + col] : 0.f;
    uint4 o; o.x = pk2(v[0], v[1]); o.y = pk2(v[2], v[3]); o.z = pk2(v[4], v[5]); o.w = pk2(v[6], v[7]);
    *(uint4*)(dst + (size_t)nd * K + k0) = o;
  }
}

DI void phase_convert(const Params& p, int layer) {
  const int kind = layer % 3, j = layer / 3;
  convert_w(p.in[8] + (size_t)layer * DM * DFF, p.in[9] + (size_t)layer * DM * DFF, DFF, DM, (bf16_t*)(p.ws + OFF_W13), 2 * DFF, 1);
  convert_w(p.in[10] + (size_t)layer * DFF * DM, nullptr, DM, DFF, (bf16_t*)(p.ws + OFF_W2), DM, 0);
  char* mix = p.ws + OFF_MIX;
  if (kind == 0) {
    convert_w(p.in[11] + (size_t)j * 1024 * 704, nullptr, 704, 1024, (bf16_t*)(mix), 768, 0);
    convert_w(p.in[14] + (size_t)j * 384 * 1536, nullptr, 1536, 384, (bf16_t*)(mix + 1572864), 1536, 2);
    convert_w(p.in[15] + (size_t)j * 256 * 2048, nullptr, 2048, 256, (bf16_t*)(mix + 2752512), 2048, 0);
    convert_w(p.in[20] + (size_t)j * 1024 * 1024, nullptr, 1024, 1024, (bf16_t*)(mix + 3801088), 1024, 0);
  } else if (kind == 1) {
    convert_w(p.in[21] + (size_t)j * 1024 * 5120, nullptr, 5120, 1024, (bf16_t*)(mix), 5120, 0);
    convert_w(p.in[24] + (size_t)j * 1024 * 1024, nullptr, 1024, 1024, (bf16_t*)(mix + 10485760), 1024, 0);
  } else {
    convert_w(p.in[25] + (size_t)j * 1024 * 3072, nullptr, 3072, 1024, (bf16_t*)(mix), 3072, 0);
    convert_w(p.in[30] + (size_t)j * 1024 * 1024, nullptr, 1024, 1024, (bf16_t*)(mix + 6291456), 1024, 0);
  }
}

DI void phase_norm(const Params& p, const float* nw, const float* modsL, int selShift, int selScale, bool skipctx) {
  const int lane = TID() & 63, wv = TID() >> 6;
  bf16_t* abuf = (bf16_t*)(p.ws + OFF_ABUF);
  const int stride = gridDim.x * 8;
  int r = BID() * 8 + wv;
  float4 w[4];
#pragma unroll
  for (int q = 0; q < 4; ++q) w[q] = *(const float4*)(nw + (lane + 64 * q) * 4);
  float4 v[4], vn[4];
  if (r < NT) {
    const float4* x = (const float4*)xrow(p, r);
#pragma unroll
    for (int q = 0; q < 4; ++q) v[q] = x[lane + 64 * q];
  }
  for (; r < NT; r += stride) {
    const int rn = r + stride;
    if (rn < NT) {
      const float4* xn = (const float4*)xrow(p, rn);
#pragma unroll
      for (int q = 0; q < 4; ++q) vn[q] = xn[lane + 64 * q];
    }
    const int b = r / PL, pp = r - b * PL;
    const bool isctx = pp < CTXL;
    if (!(skipctx && isctx)) {
      const float* md = modsL + (size_t)(isctx ? 4 : b) * 6144;
      float ss = 0.f;
#pragma unroll
      for (int q = 0; q < 4; ++q) ss += v[q].x * v[q].x + v[q].y * v[q].y + v[q].z * v[q].z + v[q].w * v[q].w;
      ss = wave_sum(ss);
      const float rs = rsqrtf(ss * (1.f / 1024.f) + EPS);
#pragma unroll
      for (int q = 0; q < 4; ++q) {
        const int k0 = (lane + 64 * q) * 4;
        const float4 sc = *(const float4*)(md + selScale * 1024 + k0), sh = *(const float4*)(md + selShift * 1024 + k0);
        const float a0 = v[q].x * rs * w[q].x * (1.f + sc.x) + sh.x, a1 = v[q].y * rs * w[q].y * (1.f + sc.y) + sh.y;
        const float a2 = v[q].z * rs * w[q].z * (1.f + sc.z) + sh.z, a3 = v[q].w * rs * w[q].w * (1.f + sc.w) + sh.w;
        uint2 o; o.x = pk2(a0, a1); o.y = pk2(a2, a3);
        *(uint2*)(abuf + (size_t)r * DM + k0) = o;
      }
    }
#pragma unroll
    for (int q = 0; q < 4; ++q) v[q] = vn[q];
  }
}

constexpr int GSTR = 144;

template <int WM, bool SWAP, int NSPLIT = 0, class Epi>
DI void gemm_phase(const bf16_t* A, const bf16_t* W, int K, int ntiles, bool skipctx, const Epi& epi, char* smem) {
  constexpr int BN = 128 * WM, GBUF = (256 + BN) * GSTR;
  const int tid = TID(), lane = tid & 63, wv = tid >> 6, l31 = lane & 31, hh = lane >> 5;
  const int wm = (WM == 1) ? wv : (wv & 3), wn = (WM == 1) ? 0 : (wv >> 2);
  const int xcd = BID() & 7, slot = BID() >> 3, nslots = gridDim.x >> 3;
  const int nk = K >> 6;
  const int tiles_x = ((MT - xcd + 7) >> 3) * ntiles;
  constexpr int NSP = NSPLIT > 0 ? NSPLIT : 1;
  const int full = NSPLIT > 0 ? (tiles_x / nslots) * nslots : tiles_x;
  const int nunits = full + (tiles_x - full) * NSP;
  for (int u = slot; u < nunits; u += nslots) {
    const bool part = u >= full;
    const int q = part ? full + (u - full) / NSP : u, ks = part ? (u - full) % NSP : 0;
    const int mtl = q / ntiles, nt = q - mtl * ntiles, mt = mtl * 8 + xcd;
    if (skipctx && (mt % PT) == 0) continue;
    const int kt0 = part ? (ks * nk) / NSP : 0, kt1 = part ? ((ks + 1) * nk) / NSP : nk;
    const bf16_t* Ag = A + (size_t)mt * 256 * K;
    const bf16_t* Wg = W + (size_t)nt * BN * K;
    f32x16 acc[WM][4];
#pragma unroll
    for (int mi = 0; mi < WM; ++mi)
#pragma unroll
      for (int nb = 0; nb < 4; ++nb)
#pragma unroll
        for (int i = 0; i < 16; ++i) acc[mi][nb][i] = 0.f;
    uint4 ra0, ra1, ra2, ra3, rw0, rw1, rw2, rw3;
    rw2 = make_uint4(0, 0, 0, 0); rw3 = rw2;
    const int grow = tid >> 3, gcol = (tid & 7) * 8;
    const bf16_t* ap = Ag + (size_t)grow * K + gcol;
    const bf16_t* wp = Wg + (size_t)grow * K + gcol;
    const int lo = grow * GSTR + (tid & 7) * 16;
#define GLOADG(kt_) do { const int ko_ = (kt_) * 64; \
      ra0 = *(const uint4*)(ap + ko_); ra1 = *(const uint4*)(ap + (size_t)64 * K + ko_); ra2 = *(const uint4*)(ap + (size_t)128 * K + ko_); ra3 = *(const uint4*)(ap + (size_t)192 * K + ko_); \
      rw0 = *(const uint4*)(wp + ko_); rw1 = *(const uint4*)(wp + (size_t)64 * K + ko_); \
      if (WM == 2) { rw2 = *(const uint4*)(wp + (size_t)128 * K + ko_); rw3 = *(const uint4*)(wp + (size_t)192 * K + ko_); } } while (0)
#define SSTOREG(buf_) do { char* b_ = (buf_) + lo; \
      *(uint4*)(b_) = ra0; *(uint4*)(b_ + 64 * GSTR) = ra1; *(uint4*)(b_ + 128 * GSTR) = ra2; *(uint4*)(b_ + 192 * GSTR) = ra3; \
      *(uint4*)(b_ + 256 * GSTR) = rw0; *(uint4*)(b_ + 320 * GSTR) = rw1; \
      if (WM == 2) { *(uint4*)(b_ + 384 * GSTR) = rw2; *(uint4*)(b_ + 448 * GSTR) = rw3; } } while (0)
    GLOADG(kt0); SSTOREG(smem);
    if (WM == 2) GLOADG(kt0 + 1 < kt1 ? kt0 + 1 : kt0);
    __syncthreads();
    for (int kt = kt0; kt < kt1; ++kt) {
      const char* cur = smem + ((kt - kt0) & 1) * GBUF;
      if (WM == 1) { GLOADG(kt + 1 < kt1 ? kt + 1 : kt); PIN(); }
      const char* ab = cur + (wm * 32 * WM + l31) * GSTR + hh * 16;
      const char* wb = cur + (256 + wn * 128 + l31) * GSTR + hh * 16;
      bf16x8 tfA, tfA1, tfB, tfB1, wfA0, wfA1, wfA2, wfA3, wfB0, wfB1, wfB2, wfB3;
#define LDFR(tf_, tf1_, w0_, w1_, w2_, w3_, s_) do { tf_ = *(const bf16x8*)(ab + (s_) * 32); if (WM == 2) tf1_ = *(const bf16x8*)(ab + 32 * GSTR + (s_) * 32); \
        w0_ = *(const bf16x8*)(wb + (s_) * 32); w1_ = *(const bf16x8*)(wb + 32 * GSTR + (s_) * 32); \
        w2_ = *(const bf16x8*)(wb + 64 * GSTR + (s_) * 32); w3_ = *(const bf16x8*)(wb + 96 * GSTR + (s_) * 32); } while (0)
#define DOMM1(mi_, tf_, w0_, w1_, w2_, w3_) do { if (SWAP) { acc[mi_][0] = MFMA(w0_, tf_, acc[mi_][0]); acc[mi_][1] = MFMA(w1_, tf_, acc[mi_][1]); acc[mi_][2] = MFMA(w2_, tf_, acc[mi_][2]); acc[mi_][3] = MFMA(w3_, tf_, acc[mi_][3]); } \
        else { acc[mi_][0] = MFMA(tf_, w0_, acc[mi_][0]); acc[mi_][1] = MFMA(tf_, w1_, acc[mi_][1]); acc[mi_][2] = MFMA(tf_, w2_, acc[mi_][2]); acc[mi_][3] = MFMA(tf_, w3_, acc[mi_][3]); } } while (0)
#define DOMM(tf_, tf1_, w0_, w1_, w2_, w3_) do { DOMM1(0, tf_, w0_, w1_, w2_, w3_); if (WM == 2) DOMM1(WM - 1, tf1_, w0_, w1_, w2_, w3_); } while (0)
      if (WM == 1) {
        LDFR(tfA, tfA1, wfA0, wfA1, wfA2, wfA3, 0);
        LDFR(tfB, tfB1, wfB0, wfB1, wfB2, wfB3, 1);
        PIN();
        DOMM(tfA, tfA1, wfA0, wfA1, wfA2, wfA3);
        PIN();
        LDFR(tfA, tfA1, wfA0, wfA1, wfA2, wfA3, 2);
        PIN();
        DOMM(tfB, tfB1, wfB0, wfB1, wfB2, wfB3);
        PIN();
        LDFR(tfB, tfB1, wfB0, wfB1, wfB2, wfB3, 3);
        PIN();
        DOMM(tfA, tfA1, wfA0, wfA1, wfA2, wfA3);
        DOMM(tfB, tfB1, wfB0, wfB1, wfB2, wfB3);
      } else {
        char* nb_ = smem + ((kt + 1 - kt0) & 1) * GBUF + lo;
#define MM2(mi_, tf_, wa_, wb_, na_, nb2_) do { if (SWAP) { acc[mi_][na_] = MFMA(wa_, tf_, acc[mi_][na_]); acc[mi_][nb2_] = MFMA(wb_, tf_, acc[mi_][nb2_]); } \
          else { acc[mi_][na_] = MFMA(tf_, wa_, acc[mi_][na_]); acc[mi_][nb2_] = MFMA(tf_, wb_, acc[mi_][nb2_]); } } while (0)
        LDFR(tfA, tfA1, wfA0, wfA1, wfA2, wfA3, 0);
        PIN();
        DOMM(tfA, tfA1, wfA0, wfA1, wfA2, wfA3);
        PIN();
        LDFR(tfA, tfA1, wfA0, wfA1, wfA2, wfA3, 1);
        PIN();
        DOMM(tfA, tfA1, wfA0, wfA1, wfA2, wfA3);
        PIN();
        LDFR(tfA, tfA1, wfA0, wfA1, wfA2, wfA3, 2);
        PIN();
        MM2(0, tfA, wfA0, wfA1, 0, 1); PIN(); *(uint4*)(nb_) = ra0; PIN();
        MM2(0, tfA, wfA2, wfA3, 2, 3); PIN(); *(uint4*)(nb_ + 64 * GSTR) = ra1; PIN();
        MM2(1, tfA1, wfA0, wfA1, 0, 1); PIN(); *(uint4*)(nb_ + 128 * GSTR) = ra2; PIN();
        MM2(1, tfA1, wfA2, wfA3, 2, 3); PIN(); *(uint4*)(nb_ + 192 * GSTR) = ra3; PIN();
        LDFR(tfA, tfA1, wfA0, wfA1, wfA2, wfA3, 3);
        PIN();
        MM2(0, tfA, wfA0, wfA1, 0, 1); PIN(); *(uint4*)(nb_ + 256 * GSTR) = rw0; PIN();
        MM2(0, tfA, wfA2, wfA3, 2, 3); PIN(); *(uint4*)(nb_ + 320 * GSTR) = rw1; PIN();
        MM2(1, tfA1, wfA0, wfA1, 0, 1); PIN(); *(uint4*)(nb_ + 384 * GSTR) = rw2; PIN();
        MM2(1, tfA1, wfA2, wfA3, 2, 3); PIN(); *(uint4*)(nb_ + 448 * GSTR) = rw3; PIN();
        GLOADG(kt + 2 < kt1 ? kt + 2 : kt);
#undef MM2
      }
#undef LDFR
#undef DOMM
#undef DOMM1
      PIN();
      if (WM == 1) { if (kt + 1 < kt1) SSTOREG(smem + ((kt + 1 - kt0) & 1) * GBUF); }
      __syncthreads();
    }
#pragma unroll
    for (int mi = 0; mi < WM; ++mi) epi(acc[mi], __builtin_amdgcn_readfirstlane(mt * 256 + (wm * WM + mi) * 32), __builtin_amdgcn_readfirstlane(nt * WM + wn), lane, part);
  }
#undef GLOADG
#undef SSTOREG
}

template <int WM, bool SWAP, int NSPLIT = 0, class Epi>
DI void gemm_phase_pref(const bf16_t* A, const bf16_t* W, int K, int ntiles, bool skipctx, const Epi& epi, char* smem) {
  constexpr int BN = 128 * WM, GBUF = (256 + BN) * GSTR;
  const int tid = TID(), lane = tid & 63, wv = tid >> 6, l31 = lane & 31, hh = lane >> 5;
  const int wm = (WM == 1) ? wv : (wv & 3), wn = (WM == 1) ? 0 : (wv >> 2);
  const int xcd = BID() & 7, slot = BID() >> 3, nslots = gridDim.x >> 3;
  const int nk = K >> 6;
  const int tiles_x = ((MT - xcd + 7) >> 3) * ntiles;
  constexpr int NSP = NSPLIT > 0 ? NSPLIT : 1;
  const int full = NSPLIT > 0 ? (tiles_x / nslots) * nslots : tiles_x;
  const int nunits = full + (tiles_x - full) * NSP;
  uint4 ra0, ra1, ra2, ra3, rw0, rw1, rw2, rw3;
  rw2 = make_uint4(0, 0, 0, 0); rw3 = rw2;
  const int grow = tid >> 3, gcol = (tid & 7) * 8;
  const int lo = grow * GSTR + (tid & 7) * 16;
  const bf16_t* ap = A; const bf16_t* wp = W;
#define GLOADG(kt_) do { const int ko_ = (kt_) * 64; \
      ra0 = *(const uint4*)(ap + ko_); ra1 = *(const uint4*)(ap + (size_t)64 * K + ko_); ra2 = *(const uint4*)(ap + (size_t)128 * K + ko_); ra3 = *(const uint4*)(ap + (size_t)192 * K + ko_); \
      rw0 = *(const uint4*)(wp + ko_); rw1 = *(const uint4*)(wp + (size_t)64 * K + ko_); \
      if (WM == 2) { rw2 = *(const uint4*)(wp + (size_t)128 * K + ko_); rw3 = *(const uint4*)(wp + (size_t)192 * K + ko_); } } while (0)
#define SSTOREG(buf_) do { char* b_ = (buf_) + lo; \
      *(uint4*)(b_) = ra0; *(uint4*)(b_ + 64 * GSTR) = ra1; *(uint4*)(b_ + 128 * GSTR) = ra2; *(uint4*)(b_ + 192 * GSTR) = ra3; \
      *(uint4*)(b_ + 256 * GSTR) = rw0; *(uint4*)(b_ + 320 * GSTR) = rw1; \
      if (WM == 2) { *(uint4*)(b_ + 384 * GSTR) = rw2; *(uint4*)(b_ + 448 * GSTR) = rw3; } } while (0)
#define UNIT_DECODE(u_, mt_, nt_, kt0_, kt1_, part_) do { part_ = (u_) >= full; \
      const int q_ = part_ ? full + ((u_) - full) / NSP : (u_), ks_ = part_ ? ((u_) - full) % NSP : 0; \
      const int mtl_ = q_ / ntiles; nt_ = q_ - mtl_ * ntiles; mt_ = mtl_ * 8 + xcd; \
      kt0_ = part_ ? (ks_ * nk) / NSP : 0; kt1_ = part_ ? ((ks_ + 1) * nk) / NSP : nk; } while (0)
  int u = slot, mt = 0, nt = 0, kt0 = 0, kt1 = 0; bool part = false;
  for (; u < nunits; u += nslots) { UNIT_DECODE(u, mt, nt, kt0, kt1, part); if (!(skipctx && (mt % PT) == 0)) break; }
  if (u < nunits) { ap = A + (size_t)mt * 256 * K + (size_t)grow * K + gcol; wp = W + (size_t)nt * BN * K + (size_t)grow * K + gcol; GLOADG(kt0); }
  while (u < nunits) {
    f32x16 acc[WM][4];
#pragma unroll
    for (int mi = 0; mi < WM; ++mi)
#pragma unroll
      for (int nb = 0; nb < 4; ++nb)
#pragma unroll
        for (int i = 0; i < 16; ++i) acc[mi][nb][i] = 0.f;
    SSTOREG(smem);
    if (WM == 2) GLOADG(kt0 + 1 < kt1 ? kt0 + 1 : kt0);
    __syncthreads();
    for (int kt = kt0; kt < kt1; ++kt) {
      const char* cur = smem + ((kt - kt0) & 1) * GBUF;
      if (WM == 1) { GLOADG(kt + 1 < kt1 ? kt + 1 : kt); PIN(); }
      const char* ab = cur + (wm * 32 * WM + l31) * GSTR + hh * 16;
      const char* wb = cur + (256 + wn * 128 + l31) * GSTR + hh * 16;
      bf16x8 tfA, tfA1, tfB, tfB1, wfA0, wfA1, wfA2, wfA3, wfB0, wfB1, wfB2, wfB3;
#define LDFR(tf_, tf1_, w0_, w1_, w2_, w3_, s_) do { tf_ = *(const bf16x8*)(ab + (s_) * 32); if (WM == 2) tf1_ = *(const bf16x8*)(ab + 32 * GSTR + (s_) * 32); \
        w0_ = *(const bf16x8*)(wb + (s_) * 32); w1_ = *(const bf16x8*)(wb + 32 * GSTR + (s_) * 32); \
        w2_ = *(const bf16x8*)(wb + 64 * GSTR + (s_) * 32); w3_ = *(const bf16x8*)(wb + 96 * GSTR + (s_) * 32); } while (0)
#define DOMM1(mi_, tf_, w0_, w1_, w2_, w3_) do { if (SWAP) { acc[mi_][0] = MFMA(w0_, tf_, acc[mi_][0]); acc[mi_][1] = MFMA(w1_, tf_, acc[mi_][1]); acc[mi_][2] = MFMA(w2_, tf_, acc[mi_][2]); acc[mi_][3] = MFMA(w3_, tf_, acc[mi_][3]); } \
        else { acc[mi_][0] = MFMA(tf_, w0_, acc[mi_][0]); acc[mi_][1] = MFMA(tf_, w1_, acc[mi_][1]); acc[mi_][2] = MFMA(tf_, w2_, acc[mi_][2]); acc[mi_][3] = MFMA(tf_, w3_, acc[mi_][3]); } } while (0)
#define DOMM(tf_, tf1_, w0_, w1_, w2_, w3_) do { DOMM1(0, tf_, w0_, w1_, w2_, w3_); if (WM == 2) DOMM1(WM - 1, tf1_, w0_, w1_, w2_, w3_); } while (0)
      if (WM == 1) {
        LDFR(tfA, tfA1, wfA0, wfA1, wfA2, wfA3, 0);
        LDFR(tfB, tfB1, wfB0, wfB1, wfB2, wfB3, 1);
        PIN();
        DOMM(tfA, tfA1, wfA0, wfA1, wfA2, wfA3);
        PIN();
        LDFR(tfA, tfA1, wfA0, wfA1, wfA2, wfA3, 2);
        PIN();
        DOMM(tfB, tfB1, wfB0, wfB1, wfB2, wfB3);
        PIN();
        LDFR(tfB, tfB1, wfB0, wfB1, wfB2, wfB3, 3);
        PIN();
        DOMM(tfA, tfA1, wfA0, wfA1, wfA2, wfA3);
        DOMM(tfB, tfB1, wfB0, wfB1, wfB2, wfB3);
      } else {
        char* nb_ = smem + ((kt + 1 - kt0) & 1) * GBUF + lo;
#define MM2(mi_, tf_, wa_, wb_, na_, nb2_) do { if (SWAP) { acc[mi_][na_] = MFMA(wa_, tf_, acc[mi_][na_]); acc[mi_][nb2_] = MFMA(wb_, tf_, acc[mi_][nb2_]); } \
          else { acc[mi_][na_] = MFMA(tf_, wa_, acc[mi_][na_]); acc[mi_][nb2_] = MFMA(tf_, wb_, acc[mi_][nb2_]); } } while (0)
        LDFR(tfA, tfA1, wfA0, wfA1, wfA2, wfA3, 0);
        PIN();
        DOMM(tfA, tfA1, wfA0, wfA1, wfA2, wfA3);
        PIN();
        LDFR(tfA, tfA1, wfA0, wfA1, wfA2, wfA3, 1);
        PIN();
        DOMM(tfA, tfA1, wfA0, wfA1, wfA2, wfA3);
        PIN();
        LDFR(tfA, tfA1, wfA0, wfA1, wfA2, wfA3, 2);
        PIN();
        MM2(0, tfA, wfA0, wfA1, 0, 1); PIN(); *(uint4*)(nb_) = ra0; PIN();
        MM2(0, tfA, wfA2, wfA3, 2, 3); PIN(); *(uint4*)(nb_ + 64 * GSTR) = ra1; PIN();
        MM2(1, tfA1, wfA0, wfA1, 0, 1); PIN(); *(uint4*)(nb_ + 128 * GSTR) = ra2; PIN();
        MM2(1, tfA1, wfA2, wfA3, 2, 3); PIN(); *(uint4*)(nb_ + 192 * GSTR) = ra3; PIN();
        LDFR(tfA, tfA1, wfA0, wfA1, wfA2, wfA3, 3);
        PIN();
        MM2(0, tfA, wfA0, wfA1, 0, 1); PIN(); *(uint4*)(nb_ + 256 * GSTR) = rw0; PIN();
        MM2(0, tfA, wfA2, wfA3, 2, 3); PIN(); *(uint4*)(nb_ + 320 * GSTR) = rw1; PIN();
        MM2(1, tfA1, wfA0, wfA1, 0, 1); PIN(); *(uint4*)(nb_ + 384 * GSTR) = rw2; PIN();
        MM2(1, tfA1, wfA2, wfA3, 2, 3); PIN(); *(uint4*)(nb_ + 448 * GSTR) = rw3; PIN();
        GLOADG(kt + 2 < kt1 ? kt + 2 : kt);
#undef MM2
      }
#undef LDFR
#undef DOMM
#undef DOMM1
      PIN();
      if (WM == 1) { if (kt + 1 < kt1) SSTOREG(smem + ((kt + 1 - kt0) & 1) * GBUF); }
      __syncthreads();
    }
    const int cmt = mt, cnt = nt; const bool cpart = part;
    for (u += nslots; u < nunits; u += nslots) { UNIT_DECODE(u, mt, nt, kt0, kt1, part); if (!(skipctx && (mt % PT) == 0)) break; }
    if (u < nunits) { ap = A + (size_t)mt * 256 * K + (size_t)grow * K + gcol; wp = W + (size_t)nt * BN * K + (size_t)grow * K + gcol; GLOADG(kt0); }
    PIN();
#pragma unroll
    for (int mi = 0; mi < WM; ++mi) epi(acc[mi], __builtin_amdgcn_readfirstlane(cmt * 256 + (wm * WM + mi) * 32), __builtin_amdgcn_readfirstlane(cnt * WM + wn), lane, cpart);
  }
#undef GLOADG
#undef SSTOREG
#undef UNIT_DECODE
}

struct EpiX {
  const Params* p; const float* gate; float sc;
  DI void operator()(f32x16 (&acc)[4], int tok0, int nt, int lane, bool part = false) const {
    const int l31 = lane & 31, hh = lane >> 5;
    const int b = tok0 / PL, pp0 = tok0 - b * PL;
    const float* g = gate + (size_t)(pp0 < CTXL ? 4 : b) * 6144;
    float* xb = pp0 < CTXL ? (float*)(p->ws + OFF_CTXX) + (size_t)(b * CTXL + pp0) * DM : p->out + (size_t)(b * SEQ + pp0 - CTXL) * DM;
    float gv[4];
#pragma unroll
    for (int nb = 0; nb < 4; ++nb) gv[nb] = g[nt * 128 + nb * 32 + l31] * sc;
    float* xc = xb + nt * 128;
    const int loff = l31 + hh * 4 * DM;
    if (part) {
#pragma unroll
      for (int nb = 0; nb < 4; ++nb)
#pragma unroll
        for (int i = 0; i < 16; ++i) (void)__hip_atomic_fetch_add(xc + ((i & 3) + 8 * (i >> 2)) * DM + nb * 32 + loff, gv[nb] * acc[nb][i], __ATOMIC_RELAXED, __HIP_MEMORY_SCOPE_AGENT);
    } else {
      float xa[16], xb2[16];
#define XLD(dst_, nb_) _Pragma("unroll") for (int i = 0; i < 16; ++i) dst_[i] = (xc + ((i & 3) + 8 * (i >> 2)) * DM + (nb_) * 32)[loff]
#define XST(src_, nb_) _Pragma("unroll") for (int i = 0; i < 16; ++i) (xc + ((i & 3) + 8 * (i >> 2)) * DM + (nb_) * 32)[loff] = src_[i] + gv[nb_] * acc[nb_][i]
      XLD(xa, 0); XLD(xb2, 1); PIN();
      XST(xa, 0); PIN(); XLD(xa, 2); PIN();
      XST(xb2, 1); PIN(); XLD(xb2, 3); PIN();
      XST(xa, 2); PIN();
      XST(xb2, 3);
#undef XLD
#undef XST
    }
  }
};
DI void store_cols32_bf16_paired(const float (&v)[16], bf16_t* blk, int pitch, int l31, int hh) {
  const bool odd = (l31 & 1) != 0;
  bf16_t* p0 = blk + (size_t)(4 * hh + (odd ? 1 : 0)) * pitch + (l31 & ~1);
#pragma unroll
  for (int i = 0; i < 16; i += 2) {
    const float send = odd ? v[i] : v[i + 1];
    const float recv = __int_as_float(__builtin_amdgcn_update_dpp(0, __float_as_int(send), 0xB1, 0xF, 0xF, true));
    const unsigned w = odd ? pk2(recv, v[i + 1]) : pk2(v[i], recv);
    *(unsigned*)(p0 + (size_t)((i & 3) + 8 * (i >> 2)) * pitch) = w;
  }
}
struct EpiFfnUp {
  bf16_t* h;
  DI void operator()(f32x16 (&acc)[4], int tok0, int nt, int lane, bool part = false) const {
    const int l31 = lane & 31, hh = lane >> 5;
#pragma unroll
    for (int gg = 0; gg < 2; ++gg) {
      float hv[16];
#pragma unroll
      for (int i = 0; i < 16; ++i) hv[i] = siluf(acc[2 * gg][i]) * acc[2 * gg + 1][i];
      store_cols32_bf16_paired(hv, h + (size_t)tok0 * DFF + (nt * 2 + gg) * 32, DFF, l31, hh);
    }
  }
};
struct EpiMlaIn {
  float* raw;
  DI void operator()(f32x16 (&acc)[4], int tok0, int nt, int lane, bool part = false) const {
    const int l31 = lane & 31, hh = lane >> 5;
#pragma unroll
    for (int nb = 0; nb < 4; ++nb) {
      int col = nt * 128 + nb * 32 + l31;
      if (col < 704) {
#pragma unroll
        for (int i = 0; i < 16; ++i) raw[(size_t)(tok0 + crow(i, hh)) * 704 + col] = acc[nb][i];
      }
    }
  }
};
struct EpiHgIn {
  char* ws;
  DI void operator()(f32x16 (&acc)[4], int tok0, int nt, int lane, bool part = false) const {
    const int l31 = lane & 31, hh = lane >> 5;
    const int sec = nt >> 3;
    bf16_t* dst = (bf16_t*)(ws + HG_Q + (size_t)sec * ACT16);
    const float* lb = (const float*)(ws + OFF_LB);
#pragma unroll
    for (int nb = 0; nb < 4; ++nb) {
      int col = (nt & 7) * 128 + nb * 32 + l31;
      float oml = 1.f;
      if (sec == 1) oml = 1.f - lb[col]; else if (sec == 2) oml = 1.f - lb[1024 + col];
      float ov[16];
#pragma unroll
      for (int i = 0; i < 16; ++i) {
        float v = acc[nb][i], o;
        if (sec == 1 || sec == 2) o = oml * sigmf(-v);
        else if (sec == 4) o = siluf(v);
        else o = v;
        ov[i] = o;
      }
      store_cols32_bf16_paired(ov, dst + (size_t)tok0 * DM + (nt & 7) * 128 + nb * 32, DM, l31, hh);
    }
  }
};

DI void store_block32_packed(uint2 (&o)[4], bf16_t* blk, int hh) {
#pragma unroll
  for (int k = 0; k < 4; k += 2) {
    const auto rx = __builtin_amdgcn_permlane32_swap(o[k].x, o[k + 1].x, false, false);
    const auto ry = __builtin_amdgcn_permlane32_swap(o[k].y, o[k + 1].y, false, false);
    *(uint4*)(blk + 8 * k + 8 * hh) = make_uint4(rx[0], ry[0], rx[1], ry[1]);
  }
}
DI void norm128_store(f32x16 (&acc)[4], const float* w, bf16_t* dst, int hh) {
  float ss = 0.f;
#pragma unroll
  for (int nb = 0; nb < 4; ++nb)
#pragma unroll
    for (int i = 0; i < 16; ++i) ss += acc[nb][i] * acc[nb][i];
  ss += __shfl_xor(ss, 32);
  float rs = rsqrtf(ss * (1.f / 128.f) + EPS);
#pragma unroll
  for (int nb = 0; nb < 4; ++nb) {
    uint2 o[4];
#pragma unroll
    for (int g = 0; g < 4; ++g) {
      int f = nb * 32 + 8 * g + 4 * hh;
      float4 wv4 = *(const float4*)(w + f);
      o[g].x = pk2(acc[nb][4 * g] * rs * wv4.x, acc[nb][4 * g + 1] * rs * wv4.y);
      o[g].y = pk2(acc[nb][4 * g + 2] * rs * wv4.z, acc[nb][4 * g + 3] * rs * wv4.w);
    }
    store_block32_packed(o, dst + nb * 32, hh);
  }
}
DI void norm64_rope_store(f32x16& a0, f32x16& a1, const float* w, bf16_t* dst, int hh, bool rope, int prow, int pcol, const float* cosT, const float* sinT) {
  float ss = 0.f;
#pragma unroll
  for (int i = 0; i < 16; ++i) ss += a0[i] * a0[i] + a1[i] * a1[i];
  ss += __shfl_xor(ss, 32);
  float rs = rsqrtf(ss * (1.f / 64.f) + EPS);
#pragma unroll
  for (int i = 0; i < 16; ++i) { int f = crow(i, hh); a0[i] = a0[i] * rs * w[f]; a1[i] = a1[i] * rs * w[32 + f]; }
  if (rope) {
#pragma unroll
    for (int i = 0; i < 8; ++i) {
      int j = crow(i, hh);
      float c0 = cosT[prow * 16 + j], s0 = sinT[prow * 16 + j], c1 = cosT[pcol * 16 + j], s1 = sinT[pcol * 16 + j];
      float t1 = a0[i], t2 = a0[i + 8];
      a0[i] = t1 * c0 - t2 * s0; a0[i + 8] = t2 * c0 + t1 * s0;
      float t3 = a1[i], t4 = a1[i + 8];
      a1[i] = t3 * c1 - t4 * s1; a1[i + 8] = t4 * c1 + t3 * s1;
    }
  }
  uint2 o0[4], o1[4];
#pragma unroll
  for (int g = 0; g < 4; ++g) {
    o0[g].x = pk2(a0[4 * g], a0[4 * g + 1]); o0[g].y = pk2(a0[4 * g + 2], a0[4 * g + 3]);
    o1[g].x = pk2(a1[4 * g], a1[4 * g + 1]); o1[g].y = pk2(a1[4 * g + 2], a1[4 * g + 3]);
  }
  store_block32_packed(o0, dst, hh);
  store_block32_packed(o1, dst + 32, hh);
}
DI void vt_store(f32x16 (&acc)[4], bf16_t* vt  , int pos0, int hh) {
  const int kq = pos0 & 15, pos = (pos0 & ~15) | (8 * ((kq >> 2) & 1) + (kq & 3) + 4 * (kq >> 3));
#pragma unroll
  for (int nb = 0; nb < 4; ++nb)
#pragma unroll
    for (int i = 0; i < 16; ++i) vt[(size_t)(nb * 32 + crow(i, hh)) * PL + pos] = f2bf(acc[nb][i]);
}

struct EpiMlaUq {
  char* ws; const float* qn_w; const float* qr_w;
  DI void operator()(f32x16 (&acc)[4], int tok0, int nt, int lane, bool part = false) const {
    const int l31 = lane & 31, hh = lane >> 5;
    const int b = tok0 / PL, pos = tok0 - b * PL + l31, pt = (pos < CTXL) ? 0 : 1;
    bf16_t* Q = (bf16_t*)(ws + MLA_Q);
    if (nt < 8) {
      norm128_store(acc, qn_w, Q + ((size_t)(b * 8 + nt) * PL + pos) * 192, hh);
    } else {
      const bool rope = pt != 0; const int t = pos - CTXL;
      const float* cosT = (const float*)(ws + OFF_COS); const float* sinT = (const float*)(ws + OFF_SIN);
      int h0 = (nt - 8) * 2;
      norm64_rope_store(acc[0], acc[1], qr_w, Q + ((size_t)(b * 8 + h0) * PL + pos) * 192 + 128, hh, rope, rope ? (t >> 6) : 0, rope ? (t & 63) : 0, cosT, sinT);
      norm64_rope_store(acc[2], acc[3], qr_w, Q + ((size_t)(b * 8 + h0 + 1) * PL + pos) * 192 + 128, hh, rope, rope ? (t >> 6) : 0, rope ? (t & 63) : 0, cosT, sinT);
    }
  }
};
struct EpiMlaUkv {
  char* ws; const float* kn_w;
  DI void operator()(f32x16 (&acc)[4], int tok0, int nt, int lane, bool part = false) const {
    const int l31 = lane & 31, hh = lane >> 5;
    const int b = tok0 / PL, pos = tok0 - b * PL + l31, head = nt >> 1;
    if ((nt & 1) == 0) norm128_store(acc, kn_w, (bf16_t*)(ws + MLA_K) + ((size_t)(b * 8 + head) * PL + pos) * 192, hh);
    else vt_store(acc, (bf16_t*)(ws + MLA_VT) + (size_t)(b * 8 + head) * 128 * PL, pos, hh);
  }
};
struct EpiDfQkv {
  char* ws; const float* qn_w; const float* kn_w;
  DI void operator()(f32x16 (&acc)[4], int tok0, int nt, int lane, bool part = false) const {
    const int l31 = lane & 31, hh = lane >> 5;
    const int b = tok0 / PL, pos = tok0 - b * PL + l31, pt = (pos < CTXL) ? 0 : 1;
    if (nt < 16) {
      const bool isq = nt < 8; const int head = nt & 7;
      bf16_t* dst = (bf16_t*)(ws + (isq ? DF_Q : DF_K));
      const float* w = isq ? qn_w : kn_w;
      const bool rope = pt != 0; const int t = pos - CTXL;
      const float* cosT = (const float*)(ws + OFF_COS); const float* sinT = (const float*)(ws + OFF_SIN);
      norm64_rope_store(acc[0], acc[1], w, dst + ((size_t)((b * 8 + head) * 2 + 0) * PL + pos) * 64, hh, rope, rope ? (t >> 6) : 0, rope ? (t & 63) : 0, cosT, sinT);
      norm64_rope_store(acc[2], acc[3], w, dst + ((size_t)((b * 8 + head) * 2 + 1) * PL + pos) * 64, hh, rope, rope ? (t >> 6) : 0, rope ? (t & 63) : 0, cosT, sinT);
    } else {
      vt_store(acc, (bf16_t*)(ws + DF_VT) + (size_t)(b * 8 + (nt - 16)) * 128 * PL, pos, hh);
    }
  }
};

DI void phase_mla_post(const Params& p, int j) {
  const int lane = TID() & 63, wv = TID() >> 6;
  const float* raw = (const float*)(p.ws + MLA_Q);
  bf16_t* cqn = (bf16_t*)(p.ws + MLA_CQN);
  bf16_t* ckvn = (bf16_t*)(p.ws + MLA_CKVN);
  bf16_t* Kb = (bf16_t*)(p.ws + MLA_K);
  const float* qnw = p.in[12] + j * 384; const float* kvnw = p.in[13] + j * 256; const float* krw = p.in[19] + j * 64;
  const float* cosT = (const float*)(p.ws + OFF_COS); const float* sinT = (const float*)(p.ws + OFF_SIN);
  for (int r = BID() * 8 + wv; r < NT; r += gridDim.x * 8) {
    const float* x = raw + (size_t)r * 704;
    float q[6], kv[4], kr;
    float sq = 0.f, skv = 0.f;
#pragma unroll
    for (int u = 0; u < 6; ++u) { q[u] = x[lane + 64 * u]; sq += q[u] * q[u]; }
#pragma unroll
    for (int u = 0; u < 4; ++u) { kv[u] = x[384 + lane + 64 * u]; skv += kv[u] * kv[u]; }
    kr = x[640 + lane];
    sq = wave_sum(sq); skv = wave_sum(skv);
    float skr = wave_sum(kr * kr);
    float rq = rsqrtf(sq * (1.f / 384.f) + EPS), rkv = rsqrtf(skv * (1.f / 256.f) + EPS), rkr = rsqrtf(skr * (1.f / 64.f) + EPS);
#pragma unroll
    for (int u = 0; u < 6; ++u) cqn[(size_t)r * 384 + lane + 64 * u] = f2bf(q[u] * rq * qnw[lane + 64 * u]);
#pragma unroll
    for (int u = 0; u < 4; ++u) ckvn[(size_t)r * 256 + lane + 64 * u] = f2bf(kv[u] * rkv * kvnw[lane + 64 * u]);
    float v = kr * rkr * krw[lane];
    int b = r / PL, pp = r - b * PL;
    float other = __shfl_xor(v, 16);
    if (pp >= CTXL) {
      int t = pp - CTXL, pos = (lane < 32) ? (t >> 6) : (t & 63), jf = lane & 15;
      float c = cosT[pos * 16 + jf], s = sinT[pos * 16 + jf];
      float rot = (lane & 16) ? other : -other;
      v = v * c + rot * s;
    }
    unsigned short vb = f2bf(v);
#pragma unroll
    for (int h = 0; h < 8; ++h) Kb[((size_t)(b * 8 + h) * PL + pp) * 192 + 128 + lane] = vb;
  }
}

template <int DQK, int NM>
DI void attn_item(const bf16_t* Qb, const bf16_t* Kb, size_t mstride, const bf16_t* VTb,
                  int q0, int nkt, float cs, bf16_t* Orow  , float lam, float outscale, const float* subw, char* smem) {
  constexpr int KSTR = DQK * 2 + 16, KT_BYTES = NM * 64 * KSTR, VSTR = 144, VT_BYTES = 128 * VSTR, BUF = KT_BYTES + VT_BYTES;
  constexpr int KCH = DQK / 8, NKC = NM * 64 * KCH / NTHR, WPM = 8 / NM, NS = DQK / 16;
  const int tid = TID(), lane = tid & 63, wv = tid >> 6, l31 = lane & 31, hh = lane >> 5;
  const int m = wv / WPM, wq = wv % WPM;
  const int qp = q0 + wq * 32 + l31;
  bf16x8 qf[NS];
  {
    const bf16_t* qptr = Qb + m * mstride + (size_t)qp * DQK + hh * 8;
#pragma unroll
    for (int s = 0; s < NS; ++s) qf[s] = *(const bf16x8*)(qptr + s * 16);
  }
  f32x16 oacc[4];
#pragma unroll
  for (int db = 0; db < 4; ++db)
#pragma unroll
    for (int i = 0; i < 16; ++i) oacc[db][i] = 0.f;
  float mrun = -1e30f, lrun = 0.f;
  uint4 kreg0, kreg1, kreg2, vreg0, vreg1;
  kreg2 = make_uint4(0, 0, 0, 0);
  int kgo[3], klo[3];
#pragma unroll
  for (int j = 0; j < 3; ++j) {
    int c = tid + NTHR * j, mm = c / (64 * KCH), rem = c - mm * (64 * KCH), row = rem / KCH, kc = rem - row * KCH;
    kgo[j] = row * DQK + kc * 8; klo[j] = (mm * 64 + row) * KSTR + kc * 16;
    if (NM == 2) kgo[j] += mm * (int)mstride;
  }
  const int vgo0 = (tid >> 3) * PL + (tid & 7) * 8, vgo1 = ((tid + NTHR) >> 3) * PL + (tid & 7) * 8;
  const int vlo0 = KT_BYTES + (tid >> 3) * VSTR + (tid & 7) * 16, vlo1 = KT_BYTES + ((tid + NTHR) >> 3) * VSTR + (tid & 7) * 16;
#define GLOAD(kt_) do { const bf16_t* kp_ = Kb + (size_t)(kt_) * 64 * DQK; const bf16_t* vp_ = VTb + (kt_) * 64; \
    kreg0 = *(const uint4*)(kp_ + kgo[0]); kreg1 = *(const uint4*)(kp_ + kgo[1]); if (NKC > 2) kreg2 = *(const uint4*)(kp_ + kgo[2]); \
    vreg0 = *(const uint4*)(vp_ + vgo0); vreg1 = *(const uint4*)(vp_ + vgo1); } while (0)
#define SSTORE(buf_) do { char* b_ = (buf_); \
    *(uint4*)(b_ + klo[0]) = kreg0; *(uint4*)(b_ + klo[1]) = kreg1; if (NKC > 2) *(uint4*)(b_ + klo[2]) = kreg2; \
    *(uint4*)(b_ + vlo0) = vreg0; *(uint4*)(b_ + vlo1) = vreg1; } while (0)
  GLOAD(0); SSTORE(smem); __syncthreads();
  for (int kt = 0; kt < nkt; ++kt) {
    const char* cur = smem + (kt & 1) * BUF;
    GLOAD(kt + 1 < nkt ? kt + 1 : kt);
    PIN();
    f32x16 sacc[2];
#pragma unroll
    for (int kb = 0; kb < 2; ++kb)
#pragma unroll
      for (int i = 0; i < 16; ++i) sacc[kb][i] = 0.f;
    const char* kbase = cur + (m * 64 + l31) * KSTR + hh * 16;
    {
      bf16x8 kfa[4], kfb[4];
#define KLD(dst_, s_) do { dst_[0] = *(const bf16x8*)(kbase + (s_) * 32); dst_[1] = *(const bf16x8*)(kbase + 32 * KSTR + (s_) * 32); \
        dst_[2] = *(const bf16x8*)(kbase + ((s_) + 1) * 32); dst_[3] = *(const bf16x8*)(kbase + 32 * KSTR + ((s_) + 1) * 32); } while (0)
#define KMM(src_, s_) do { sacc[0] = MFMA(src_[0], qf[s_], sacc[0]); sacc[1] = MFMA(src_[1], qf[s_], sacc[1]); \
        sacc[0] = MFMA(src_[2], qf[(s_) + 1], sacc[0]); sacc[1] = MFMA(src_[3], qf[(s_) + 1], sacc[1]); } while (0)
      KLD(kfa, 0);
#pragma unroll
      for (int g = 0; g < NS / 2; ++g) {
        PIN();
        if (g + 1 < NS / 2) { if (g & 1) KLD(kfa, 2 * g + 2); else KLD(kfb, 2 * g + 2); }
        PIN();
        if (g & 1) KMM(kfb, 2 * g); else KMM(kfa, 2 * g);
      }
#undef KLD
#undef KMM
    }
    float mx = sacc[0][0];
#pragma unroll
    for (int i = 1; i < 16; ++i) mx = fmaxf(mx, sacc[0][i]);
#pragma unroll
    for (int i = 0; i < 16; ++i) mx = fmaxf(mx, sacc[1][i]);
    {
      const auto rr = __builtin_amdgcn_permlane32_swap(__float_as_uint(mx), __float_as_uint(mx), false, false);
      mx = fmaxf(__uint_as_float(rr[0]), __uint_as_float(rr[1]));
    }
    if (__any((mx - mrun) * cs > 8.f)) {
      const float mnew = fmaxf(mrun, mx);
      const float alpha = __builtin_amdgcn_exp2f((mrun - mnew) * cs);
      mrun = mnew;
      lrun *= alpha;
#pragma unroll
      for (int db = 0; db < 4; ++db)
#pragma unroll
        for (int i = 0; i < 16; ++i) oacc[db][i] *= alpha;
    }
    {
      const f32x2_t cs2 = {cs, cs}, mc2 = {mrun * cs, mrun * cs};
      f32x2_t ps2 = {0.f, 0.f};
#pragma unroll
      for (int kb = 0; kb < 2; ++kb)
#pragma unroll
        for (int i = 0; i < 16; i += 2) {
          f32x2_t t = {sacc[kb][i], sacc[kb][i + 1]};
          t = t * cs2 - mc2;
          t.x = __builtin_amdgcn_exp2f(t.x); t.y = __builtin_amdgcn_exp2f(t.y);
          sacc[kb][i] = t.x; sacc[kb][i + 1] = t.y;
          ps2 = ps2 + t;
        }
      lrun += ps2.x + ps2.y;
    }
    const char* vbase = cur + KT_BYTES + l31 * VSTR + hh * 16;
    {
      struct VF { bf16x8 v; };
      VF vfa[4], vfb[4];
#define VLD(dst_, s4_) do { _Pragma("unroll") for (int db = 0; db < 4; ++db) dst_[db].v = *(const bf16x8*)(vbase + db * 32 * VSTR + (s4_) * 32); } while (0)
      VLD(vfa, 0);
#pragma unroll
      for (int s4 = 0; s4 < 4; ++s4) {
        const int kb = s4 >> 1, sp = s4 & 1;
        PIN();
        if (s4 < 3) { if (s4 & 1) VLD(vfa, s4 + 1); else VLD(vfb, s4 + 1); }
        union { bf16x8 v; unsigned u[4]; } pf;
#pragma unroll
        for (int e = 0; e < 4; ++e) pf.u[e] = pk2(sacc[kb][8 * sp + 2 * e], sacc[kb][8 * sp + 2 * e + 1]);
        PIN();
#pragma unroll
        for (int db = 0; db < 4; ++db) { if (s4 & 1) oacc[db] = MFMA(vfb[db].v, pf.v, oacc[db]); else oacc[db] = MFMA(vfa[db].v, pf.v, oacc[db]); }
        {
          char* b_ = smem + ((kt + 1) & 1) * BUF;
          if (s4 == 0) { *(uint4*)(b_ + klo[0]) = kreg0; if (NKC > 2) *(uint4*)(b_ + klo[2]) = kreg2; }
          if (s4 == 1) { *(uint4*)(b_ + klo[1]) = kreg1; }
          if (s4 == 2) { *(uint4*)(b_ + vlo0) = vreg0; }
          if (s4 == 3) { *(uint4*)(b_ + vlo1) = vreg1; }
        }
      }
#undef VLD
    }
    PIN();
    __syncthreads();
  }
#undef GLOAD
#undef SSTORE
  lrun += __shfl_xor(lrun, 32);
  const float inv = 1.f / lrun;
#pragma unroll
  for (int db = 0; db < 4; ++db)
#pragma unroll
    for (int i = 0; i < 16; ++i) oacc[db][i] *= inv;
  if (NM == 2) {
    float* cb = (float*)smem;
    if (m == 1) {
#pragma unroll
      for (int db = 0; db < 4; ++db)
#pragma unroll
        for (int i = 0; i < 16; ++i) cb[(wq * 64 + db * 16 + i) * 64 + lane] = oacc[db][i];
    }
    __syncthreads();
    if (m == 0) {
      float ss = 0.f;
#pragma unroll
      for (int db = 0; db < 4; ++db)
#pragma unroll
        for (int i = 0; i < 16; ++i) { float o = oacc[db][i] - lam * cb[(wq * 64 + db * 16 + i) * 64 + lane]; oacc[db][i] = o; ss += o * o; }
      ss += __shfl_xor(ss, 32);
      const float rs = rsqrtf(ss * (1.f / 128.f) + EPS) * outscale;
#pragma unroll
      for (int db = 0; db < 4; ++db)
#pragma unroll
        for (int g = 0; g < 4; ++g) {
          int d = db * 32 + 8 * g + 4 * hh;
          float4 w4 = *(const float4*)(subw + d);
          uint2 o;
          o.x = pk2(oacc[db][4 * g] * rs * w4.x, oacc[db][4 * g + 1] * rs * w4.y);
          o.y = pk2(oacc[db][4 * g + 2] * rs * w4.z, oacc[db][4 * g + 3] * rs * w4.w);
          *(uint2*)(Orow + (size_t)qp * DM + d) = o;
        }
    }
    __syncthreads();
  } else {
#pragma unroll
    for (int db = 0; db < 4; ++db) {
      uint2 o[4];
#pragma unroll
      for (int g = 0; g < 4; ++g) { o[g].x = pk2(oacc[db][4 * g], oacc[db][4 * g + 1]); o[g].y = pk2(oacc[db][4 * g + 2], oacc[db][4 * g + 3]); }
      store_block32_packed(o, Orow + (size_t)qp * DM + db * 32, hh);
    }
  }
}

DI void attn_item_df2(const bf16_t* Qb, const bf16_t* Kb, size_t mstride, const bf16_t* VTb, int q0, int nkt  , float cs,
                      bf16_t* Orow, float lam, float outscale, const float* subw, char* smem) {
  constexpr int DQK = 64, KSTR = 144, KT_BYTES = 2 * 64 * KSTR, VSTR = 144, VT_BYTES = 128 * VSTR;
  const int tid = TID(), lane = tid & 63, wv = tid >> 6, l31 = lane & 31, hh = lane >> 5;
  const int m = wv >> 2, wq = wv & 3;
  const int qp = q0 + wq * 32 + l31;
  bf16x8 qf[4];
  {
    const bf16_t* qptr = Qb + m * mstride + (size_t)qp * DQK + hh * 8;
#pragma unroll
    for (int s = 0; s < 4; ++s) qf[s] = *(const bf16x8*)(qptr + s * 16);
  }
  f32x16 oacc[4];
#pragma unroll
  for (int db = 0; db < 4; ++db)
#pragma unroll
    for (int i = 0; i < 16; ++i) oacc[db][i] = 0.f;
  float mrun = -1e30f, lrun = 0.f;
  uint4 kreg0, kreg1, vreg0, vreg1;
  const int c1 = tid + NTHR;
  const int kgo0 = (tid >> 9) * (int)mstride + ((tid & 511) >> 3) * DQK + (tid & 7) * 8, kgo1 = (c1 >> 9) * (int)mstride + ((c1 & 511) >> 3) * DQK + (c1 & 7) * 8;
  const int klo0 = ((tid >> 9) * 64 + ((tid & 511) >> 3)) * KSTR + (tid & 7) * 16, klo1 = ((c1 >> 9) * 64 + ((c1 & 511) >> 3)) * KSTR + (c1 & 7) * 16;
  const int vgo0 = (tid >> 3) * PL + (tid & 7) * 8, vgo1 = (c1 >> 3) * PL + (tid & 7) * 8;
  const int vlo0 = (tid >> 3) * VSTR + (tid & 7) * 16, vlo1 = (c1 >> 3) * VSTR + (tid & 7) * 16;
  const int kfo = (m * 64 + l31) * KSTR + hh * 16;
  const int vfo = 2 * KT_BYTES + l31 * VSTR + hh * 16;
  union PF { bf16x8 v; unsigned u[4]; };
  PF pf[4];
  f32x16 pA[2], pB[2];
#define D2_GLOAD(t_) do { const bf16_t* kp_ = Kb + (size_t)(t_) * 64 * DQK; const bf16_t* vp_ = VTb + (t_) * 64; \
    kreg0 = *(const uint4*)(kp_ + kgo0); kreg1 = *(const uint4*)(kp_ + kgo1); vreg0 = *(const uint4*)(vp_ + vgo0); vreg1 = *(const uint4*)(vp_ + vgo1); } while (0)
#define D2_SSTORE(ks_, vs_) do { char* kb_ = smem + (ks_) * KT_BYTES; char* vb_ = smem + 2 * KT_BYTES + (vs_) * VT_BYTES; \
    *(uint4*)(kb_ + klo0) = kreg0; *(uint4*)(kb_ + klo1) = kreg1; *(uint4*)(vb_ + vlo0) = vreg0; *(uint4*)(vb_ + vlo1) = vreg1; } while (0)
#define D2_RESCALE(mx_) do { if (__any(((mx_) - mrun) * cs > 8.f)) { const float mnew = fmaxf(mrun, (mx_)); const float alpha = __builtin_amdgcn_exp2f((mrun - mnew) * cs); \
      mrun = mnew; lrun *= alpha; \
      _Pragma("unroll") for (int db = 0; db < 4; ++db) _Pragma("unroll") for (int i = 0; i < 16; ++i) oacc[db][i] *= alpha; } } while (0)
#define D2_HALFMAX(mx_) do { const auto rr_ = __builtin_amdgcn_permlane32_swap(__float_as_uint(mx_), __float_as_uint(mx_), false, false); \
      mx_ = fmaxf(__uint_as_float(rr_[0]), __uint_as_float(rr_[1])); } while (0)
#define D2_FIN(prev_, step_) do { const int kbp_ = (step_) >> 2, ii_ = ((step_) & 3) * 4; \
      f32x2_t t0_ = {prev_[kbp_][ii_], prev_[kbp_][ii_ + 1]}, t1_ = {prev_[kbp_][ii_ + 2], prev_[kbp_][ii_ + 3]}; \
      t0_ = t0_ * cs2 - mc2; t1_ = t1_ * cs2 - mc2; \
      t0_.x = __builtin_amdgcn_exp2f(t0_.x); t0_.y = __builtin_amdgcn_exp2f(t0_.y); t1_.x = __builtin_amdgcn_exp2f(t1_.x); t1_.y = __builtin_amdgcn_exp2f(t1_.y); \
      ps2 = ps2 + t0_; ps2 = ps2 + t1_; \
      pf[2 * kbp_ + (ii_ >> 3)].u[(ii_ & 7) >> 1] = pk2(t0_.x, t0_.y); pf[2 * kbp_ + (ii_ >> 3)].u[((ii_ & 7) >> 1) + 1] = pk2(t1_.x, t1_.y); } while (0)
#define D2_SEG_A(cur_, prev_, ks_, FIN_) do { \
      const char* kb_ = smem + (ks_) * KT_BYTES + kfo; bf16x8 kf_[8]; \
      _Pragma("unroll") for (int st_ = 0; st_ < 8; ++st_) kf_[st_] = *(const bf16x8*)(kb_ + (st_ & 1) * 32 * KSTR + (st_ >> 1) * 32); \
      _Pragma("unroll") for (int kb2_ = 0; kb2_ < 2; ++kb2_) _Pragma("unroll") for (int i = 0; i < 16; ++i) cur_[kb2_][i] = 0.f; \
      _Pragma("unroll") for (int st_ = 0; st_ < 8; ++st_) { \
        PIN(); \
        cur_[st_ & 1] = MFMA(kf_[st_], qf[st_ >> 1], cur_[st_ & 1]); \
        if (FIN_ && (st_ & 1) == 0) { D2_FIN(prev_, (st_ >> 1)); } \
      } \
      PIN(); } while (0)
#define D2_SEG_B(cur_, prev_, vs_, MAX_, FIN2_, ST_, kns_, vns_, mx_) do { \
      const char* vb_ = smem + vfo + (vs_) * VT_BYTES; bf16x8 vfa_[4], vfb_[4]; \
      _Pragma("unroll") for (int db = 0; db < 4; ++db) vfa_[db] = *(const bf16x8*)(vb_ + db * 32 * VSTR); \
      _Pragma("unroll") for (int s4 = 0; s4 < 4; ++s4) { \
        PIN(); \
        if (s4 < 3) { _Pragma("unroll") for (int db = 0; db < 4; ++db) { if (s4 & 1) vfa_[db] = *(const bf16x8*)(vb_ + db * 32 * VSTR + (s4 + 1) * 32); else vfb_[db] = *(const bf16x8*)(vb_ + db * 32 * VSTR + (s4 + 1) * 32); } } \
        PIN(); \
        _Pragma("unroll") for (int db = 0; db < 4; ++db) { \
          if (s4 & 1) oacc[db] = MFMA(vfb_[db], pf[s4].v, oacc[db]); else oacc[db] = MFMA(vfa_[db], pf[s4].v, oacc[db]); \
          if (FIN2_ && s4 < 2 && (db & 1) == 0) { PIN(); D2_FIN(prev_, 4 + 2 * s4 + (db >> 1)); PIN(); } \
          if (MAX_ && s4 >= 2 && (db & 1) == 0) { PIN(); _Pragma("unroll") for (int i = 0; i < 8; ++i) mx_ = fmaxf(mx_, cur_[s4 - 2][(db >> 1) * 8 + i]); PIN(); } \
        } \
        if (ST_) { char* kw_ = smem + (kns_) * KT_BYTES; char* vw_ = smem + 2 * KT_BYTES + (vns_) * VT_BYTES; \
          if (s4 == 0) *(uint4*)(kw_ + klo0) = kreg0; if (s4 == 1) *(uint4*)(kw_ + klo1) = kreg1; \
          if (s4 == 2) *(uint4*)(vw_ + vlo0) = vreg0; if (s4 == 3) *(uint4*)(vw_ + vlo1) = vreg1; } \
      } \
      PIN(); } while (0)
#define D2_ITER(j_, cur_, prev_) do { \
      D2_GLOAD((j_) + 1 < nkt ? (j_) + 1 : (j_)); PIN(); \
      const f32x2_t cs2 = {cs, cs}, mc2 = {mrun * cs, mrun * cs}; f32x2_t ps2 = {0.f, 0.f}; \
      D2_SEG_A(cur_, prev_, (j_) & 1, true); \
      float mx_ = -1e30f; const int v1_ = vs0 == 2 ? 0 : vs0 + 1, v2_ = v1_ == 2 ? 0 : v1_ + 1; \
      D2_SEG_B(cur_, prev_, vs0, true, true, true, ((j_) + 1) & 1, v2_, mx_); \
      lrun += ps2.x + ps2.y; \
      D2_HALFMAX(mx_); D2_RESCALE(mx_); \
      vs0 = v1_; \
      __syncthreads(); } while (0)
  int vs0 = 0;
  D2_GLOAD(0); D2_SSTORE(0, 0); __syncthreads();
  D2_GLOAD(1); PIN();
  { const f32x2_t cs2 = {cs, cs}, mc2 = {0.f, 0.f}; f32x2_t ps2 = {0.f, 0.f}; D2_SEG_A(pA, pB, 0, false); (void)cs2; (void)mc2; (void)ps2; }
  { float mx0 = pA[0][0];
#pragma unroll
    for (int i = 1; i < 16; ++i) mx0 = fmaxf(mx0, pA[0][i]);
#pragma unroll
    for (int i = 0; i < 16; ++i) mx0 = fmaxf(mx0, pA[1][i]);
    D2_HALFMAX(mx0); D2_RESCALE(mx0); }
  PIN();
  D2_SSTORE(1, 1);
  __syncthreads();
  for (int j = 1; j < nkt - 1; j += 2) {
    D2_ITER(j, pB, pA);
    D2_ITER(j + 1, pA, pB);
  }
  D2_ITER(nkt - 1, pB, pA);
  {
    const f32x2_t cs2 = {cs, cs}, mc2 = {mrun * cs, mrun * cs}; f32x2_t ps2 = {0.f, 0.f};
#pragma unroll
    for (int st = 0; st < 8; ++st) { D2_FIN(pB, st); }
    lrun += ps2.x + ps2.y;
    float mxd = 0.f;
    D2_SEG_B(pB, pB, vs0, false, false, false, 0, 0, mxd);
  }
  __syncthreads();
#undef D2_GLOAD
#undef D2_SSTORE
#undef D2_RESCALE
#undef D2_HALFMAX
#undef D2_FIN
#undef D2_SEG_A
#undef D2_SEG_B
#undef D2_ITER
  lrun += __shfl_xor(lrun, 32);
  const float inv = 1.f / lrun;
#pragma unroll
  for (int db = 0; db < 4; ++db)
#pragma unroll
    for (int i = 0; i < 16; ++i) oacc[db][i] *= inv;
  float* cb = (float*)smem;
  if (m == 1) {
#pragma unroll
    for (int db = 0; db < 4; ++db)
#pragma unroll
      for (int i = 0; i < 16; ++i) cb[(wq * 64 + db * 16 + i) * 64 + lane] = oacc[db][i];
  }
  __syncthreads();
  if (m == 0) {
    float ss = 0.f;
#pragma unroll
    for (int db = 0; db < 4; ++db)
#pragma unroll
      for (int i = 0; i < 16; ++i) { float o = oacc[db][i] - lam * cb[(wq * 64 + db * 16 + i) * 64 + lane]; oacc[db][i] = o; ss += o * o; }
    ss += __shfl_xor(ss, 32);
    const float rs = rsqrtf(ss * (1.f / 128.f) + EPS) * outscale;
#pragma unroll
    for (int db = 0; db < 4; ++db) {
      uint2 o[4];
#pragma unroll
      for (int g = 0; g < 4; ++g) {
        int d = db * 32 + 8 * g + 4 * hh;
        float4 w4 = *(const float4*)(subw + d);
        o[g].x = pk2(oacc[db][4 * g] * rs * w4.x, oacc[db][4 * g + 1] * rs * w4.y);
        o[g].y = pk2(oacc[db][4 * g + 2] * rs * w4.z, oacc[db][4 * g + 3] * rs * w4.w);
      }
      store_block32_packed(o, Orow + (size_t)qp * DM + db * 32, hh);
    }
  }
  __syncthreads();
}

DI void phase_attn_mla(const Params& p, bool do_ctx, char* smem) {
  const bf16_t* Q = (const bf16_t*)(p.ws + MLA_Q); const bf16_t* K = (const bf16_t*)(p.ws + MLA_K); const bf16_t* VT = (const bf16_t*)(p.ws + MLA_VT);
  bf16_t* O = (bf16_t*)(p.ws + OFF_ABUF);
  const float cs = 1.4426950408889634f / sqrtf(192.f);
  const int xcd = BID() & 7, slot = BID() >> 3, nslots = gridDim.x >> 3;
  for (int q = slot; q < 4 * 32; q += nslots) {
    int bh = (q >> 5) * 8 + xcd, qb = (q & 31) + 1;
    int b = bh >> 3, h = bh & 7;
    attn_item<192, 1>(Q + (size_t)bh * PL * 192, K + (size_t)bh * PL * 192, 0, VT + (size_t)bh * 128 * PL, qb * 256, PL / 64, cs,
                      O + (size_t)b * PL * DM + h * 128, 0.f, 1.f, nullptr, smem);
  }
  if (do_ctx) {
    for (int bh = BID(); bh < 32; bh += gridDim.x) {
      int b = bh >> 3, h = bh & 7;
      attn_item<192, 1>(Q + (size_t)bh * PL * 192, K + (size_t)bh * PL * 192, 0, VT + (size_t)bh * 128 * PL, 0, CTXL / 64, cs,
                        O + (size_t)b * PL * DM + h * 128, 0.f, 1.f, nullptr, smem);
    }
  }
}

DI void phase_attn_df(const Params& p, bool do_ctx, char* smem) {
  const bf16_t* Q = (const bf16_t*)(p.ws + DF_Q); const bf16_t* K = (const bf16_t*)(p.ws + DF_K); const bf16_t* VT = (const bf16_t*)(p.ws + DF_VT);
  bf16_t* O = (bf16_t*)(p.ws + OFF_ABUF);
  const float cs = 1.4426950408889634f / sqrtf(64.f);
  const float lam = *(const float*)(p.ws + OFF_LAM);
  const float lam_init = 0.8f - 0.6f * expf(-0.3f * 2.f);
  const float* subw = p.in[29];
  const int xcd = BID() & 7, slot = BID() >> 3, nslots = gridDim.x >> 3;
  for (int q = slot; q < 4 * 64; q += nslots) {
    int bh = (q >> 6) * 8 + xcd, qb = (q & 63) + 2;
    int b = bh >> 3, h = bh & 7;
    attn_item_df2(Q + (size_t)bh * 2 * PL * 64, K + (size_t)bh * 2 * PL * 64, (size_t)PL * 64, VT + (size_t)bh * 128 * PL, qb * 128, PL / 64, cs,
                     O + (size_t)b * PL * DM + h * 128, lam, 1.f - lam_init, subw, smem);
  }
  if (do_ctx) {
    for (int it = BID(); it < 64; it += gridDim.x) {
      int bh = it >> 1, qb = it & 1;
      int b = bh >> 3, h = bh & 7;
      attn_item_df2(Q + (size_t)bh * 2 * PL * 64, K + (size_t)bh * 2 * PL * 64, (size_t)PL * 64, VT + (size_t)bh * 128 * PL, qb * 128, CTXL / 64, cs,
                       O + (size_t)b * PL * DM + h * 128, lam, 1.f - lam_init, subw, smem);
    }
  }
}

constexpr int SC_T = 32;
constexpr int SC_BUF = SC_T * 128 * 4 * 2 + SC_T * 32 * 4;
DI float dpp_row_sum16(float v) {
  v += __int_as_float(__builtin_amdgcn_update_dpp(0, __float_as_int(v), 0xB1, 0xF, 0xF, true));
  v += __int_as_float(__builtin_amdgcn_update_dpp(0, __float_as_int(v), 0x4E, 0xF, 0xF, true));
  v += __int_as_float(__builtin_amdgcn_update_dpp(0, __float_as_int(v), 0x141, 0xF, 0xF, true));
  v += __int_as_float(__builtin_amdgcn_update_dpp(0, __float_as_int(v), 0x140, 0xF, 0xF, true));
  return v;
}
DI void phase_hg_scan(const Params& p, char* smem) {
  const int tid = TID(), lane = tid & 63, wv = tid >> 6;
  const int dpart = lane & 15, esub = lane >> 4, el = wv * 4 + esub;
  const bf16_t* qb = (const bf16_t*)(p.ws + HG_Q);
  const bf16_t* ib = (const bf16_t*)(p.ws + HG_I);
  const int ltok = tid >> 4, ldc = tid & 15;
  const int vtok = (tid & 127) >> 2, vec = tid & 3;
  for (int item = BID(); item < 256; item += gridDim.x) {
    const int b = item >> 6, h = (item >> 3) & 7, dir = (item >> 2) & 1, eq = item & 3;
    const bf16_t* kk = (const bf16_t*)(p.ws + (dir ? HG_KB : HG_KF));
    bf16_t* oo = (bf16_t*)(p.ws + (dir ? HG_OB : OFF_ABUF));
    const size_t rowbase = (size_t)b * PL;
    const int colq = h * 128 + ldc * 8, colv = h * 128 + eq * 32 + vec * 8, colo = h * 128 + eq * 32 + el;
    auto posf = [&](int tau) { return dir ? (tau < CTXL ? CTXL - 1 - tau : PL - 1 - (tau - CTXL)) : tau; };
    f32x2_t S[4];
#pragma unroll
    for (int j = 0; j < 4; ++j) S[j] = f32x2_t{0.f, 0.f};
    uint4 aq, ak, av, bq, bk, bv;
    av = make_uint4(0, 0, 0, 0); bv = av;
#define SC_LOAD(rq_, rk_, rv_, c_) do { const size_t r_ = rowbase + posf((c_) * SC_T + ltok); \
      rq_ = *(const uint4*)(qb + r_ * DM + colq); rk_ = *(const uint4*)(kk + r_ * DM + colq); \
      if (tid < 128) { const size_t r2_ = rowbase + posf((c_) * SC_T + vtok); rv_ = *(const uint4*)(ib + r2_ * DM + colv); } } while (0)
#define SC_UNPK(dst_, u_) do { float4 lo_, hi_; lo_.x = __uint_as_float((u_).x << 16); lo_.y = __uint_as_float((u_).x & 0xffff0000u); lo_.z = __uint_as_float((u_).y << 16); lo_.w = __uint_as_float((u_).y & 0xffff0000u); \
      hi_.x = __uint_as_float((u_).z << 16); hi_.y = __uint_as_float((u_).z & 0xffff0000u); hi_.z = __uint_as_float((u_).w << 16); hi_.w = __uint_as_float((u_).w & 0xffff0000u); \
      *(float4*)(dst_) = lo_; *(float4*)((dst_) + 4) = hi_; } while (0)
#define SC_STORE(rq_, rk_, rv_, buf_) do { float* fb_ = (float*)(buf_); SC_UNPK(fb_ + ltok * 128 + ldc * 8, rq_); SC_UNPK(fb_ + SC_T * 128 + ltok * 128 + ldc * 8, rk_); \
      if (tid < 128) SC_UNPK(fb_ + 2 * SC_T * 128 + vtok * 32 + vec * 8, rv_); } while (0)
#define SC_COMPUTE(buf_, c_) do { const float* fb_ = (const float*)(buf_); \
      for (int t0_ = 0; t0_ < SC_T; t0_ += 16) { \
        float keep_ = 0.f; \
        _Pragma("unroll") for (int u_ = 0; u_ < 16; ++u_) { const int t_ = t0_ + u_; \
          const float4 q0_ = *(const float4*)(fb_ + t_ * 128 + dpart * 8), q1_ = *(const float4*)(fb_ + t_ * 128 + dpart * 8 + 4); \
          const float4 k0_ = *(const float4*)(fb_ + SC_T * 128 + t_ * 128 + dpart * 8), k1_ = *(const float4*)(fb_ + SC_T * 128 + t_ * 128 + dpart * 8 + 4); \
          const float v_ = fb_[2 * SC_T * 128 + t_ * 32 + el]; const f32x2_t v2_ = {v_, v_}; \
          const f32x2_t kk0_ = {k0_.x, k0_.y}, kk1_ = {k0_.z, k0_.w}, kk2_ = {k1_.x, k1_.y}, kk3_ = {k1_.z, k1_.w}; \
          const f32x2_t qq0_ = {q0_.x, q0_.y}, qq1_ = {q0_.z, q0_.w}, qq2_ = {q1_.x, q1_.y}, qq3_ = {q1_.z, q1_.w}; \
          S[0] = S[0] + kk0_ * (v2_ - S[0]); S[1] = S[1] + kk1_ * (v2_ - S[1]); S[2] = S[2] + kk2_ * (v2_ - S[2]); S[3] = S[3] + kk3_ * (v2_ - S[3]); \
          f32x2_t pp_ = S[0] * qq0_; pp_ = pp_ + S[1] * qq1_; pp_ = pp_ + S[2] * qq2_; pp_ = pp_ + S[3] * qq3_; \
          const float part_ = dpp_row_sum16(pp_.x + pp_.y); \
          keep_ = (dpart == u_) ? part_ : keep_; \
        } \
        oo[(rowbase + posf((c_) * SC_T + t0_ + dpart)) * DM + colo] = f2bf(keep_); \
      } } while (0)
    constexpr int NCH = PL / SC_T;
    SC_LOAD(aq, ak, av, 0); SC_STORE(aq, ak, av, smem);
    SC_LOAD(aq, ak, av, 1);
    __syncthreads();
    for (int c = 0; c < NCH; c += 2) {
      SC_LOAD(bq, bk, bv, (c + 2 < NCH ? c + 2 : c));
      PIN();
      SC_COMPUTE(smem, c);
      PIN();
      SC_STORE(aq, ak, av, smem + SC_BUF);
      __syncthreads();
      SC_LOAD(aq, ak, av, (c + 3 < NCH ? c + 3 : c));
      PIN();
      SC_COMPUTE(smem + SC_BUF, c + 1);
      PIN();
      SC_STORE(bq, bk, bv, smem);
      __syncthreads();
    }
#undef SC_LOAD
#undef SC_UNPK
#undef SC_STORE
#undef SC_COMPUTE
  }
}

DI void phase_hg_readout(const Params& p, int j) {
  const int lane = TID() & 63, wv = TID() >> 6;
  bf16_t* of = (bf16_t*)(p.ws + OFF_ABUF);
  const bf16_t* ob = (const bf16_t*)(p.ws + HG_OB);
  const bf16_t* sg = (const bf16_t*)(p.ws + HG_G);
  const float* onw = p.in[23] + j * 128;
  for (int r = BID() * 8 + wv; r < NT; r += gridDim.x * 8) {
    const size_t base = (size_t)r * DM + lane * 16;
    uint4 a[2], bq[2], g[2];
    a[0] = *(const uint4*)(of + base); a[1] = *(const uint4*)(of + base + 8);
    bq[0] = *(const uint4*)(ob + base); bq[1] = *(const uint4*)(ob + base + 8);
    g[0] = *(const uint4*)(sg + base); g[1] = *(const uint4*)(sg + base + 8);
    float o[16], gg[16];
#pragma unroll
    for (int u = 0; u < 2; ++u) {
      const unsigned aw[4] = {a[u].x, a[u].y, a[u].z, a[u].w}, bw[4] = {bq[u].x, bq[u].y, bq[u].z, bq[u].w}, gw[4] = {g[u].x, g[u].y, g[u].z, g[u].w};
#pragma unroll
      for (int c = 0; c < 4; ++c) {
        o[u * 8 + 2 * c] = __uint_as_float(aw[c] << 16) + __uint_as_float(bw[c] << 16);
        o[u * 8 + 2 * c + 1] = __uint_as_float(aw[c] & 0xffff0000u) + __uint_as_float(bw[c] & 0xffff0000u);
        gg[u * 8 + 2 * c] = __uint_as_float(gw[c] << 16);
        gg[u * 8 + 2 * c + 1] = __uint_as_float(gw[c] & 0xffff0000u);
      }
    }
    float ss = 0.f;
#pragma unroll
    for (int c = 0; c < 16; ++c) ss += o[c] * o[c];
    ss += __shfl_xor(ss, 1); ss += __shfl_xor(ss, 2); ss += __shfl_xor(ss, 4);
    const float rs = rsqrtf(ss * (1.f / 128.f) + EPS);
    const int d0 = (lane & 7) * 16;
    unsigned ow[8];
#pragma unroll
    for (int c = 0; c < 8; ++c) ow[c] = pk2(o[2 * c] * rs * onw[d0 + 2 * c] * gg[2 * c], o[2 * c + 1] * rs * onw[d0 + 2 * c + 1] * gg[2 * c + 1]);
    *(uint4*)(of + base) = make_uint4(ow[0], ow[1], ow[2], ow[3]);
    *(uint4*)(of + base + 8) = make_uint4(ow[4], ow[5], ow[6], ow[7]);
  }
}


#define XB_TMO      128
#define XB_XCNT(j)  (256  + 64 * (j))
#define XB_XSUB(j)  (1280 + 64 * (j))
#define XB_XGEN(j)  (2304 + 64 * (j))
#define XB_TOP      3328
#define XB_TOPGEN   3392
#define XCD_BAR_WORDS 3456
#define XB_SPIN_CAP (1u << 20)
#define LAS __attribute__((address_space(3)))
DI unsigned xb_ld(unsigned* p)              { return __hip_atomic_load(p, __ATOMIC_RELAXED, __HIP_MEMORY_SCOPE_AGENT); }
DI unsigned xb_add(unsigned* p, unsigned v) { return __hip_atomic_fetch_add(p, v, __ATOMIC_RELAXED, __HIP_MEMORY_SCOPE_AGENT); }
DI unsigned xb_xcc_id() { return (unsigned)__builtin_amdgcn_s_getreg((3 << 11) | 20) & 0xFu; }
#define XB_SPIN(cond, bar) do { unsigned _sp = 0; while (cond) { __builtin_amdgcn_s_sleep(1); \
    if ((++_sp & 255u) == 0u) { if (xb_ld(&(bar)[XB_TMO])) break; if (_sp > XB_SPIN_CAP) { atomicAdd(&(bar)[XB_TMO], 1u); break; } } } } while (0)
struct XcdBarrier { unsigned* bar; unsigned x; volatile LAS unsigned* st; };
DI XcdBarrier xcd_barrier_post(unsigned* bar, volatile LAS unsigned* st) {
  XcdBarrier b; b.bar = bar; b.x = xb_xcc_id(); b.st = st;
  if (threadIdx.x == 0) (void)xb_add(&bar[XB_XCNT(b.x)], 1u);
  return b;
}
DI void xcd_barrier_complete(unsigned* bar, unsigned x, unsigned& nloc, unsigned& nx) {
  const unsigned G = gridDim.x * gridDim.y * gridDim.z;
  unsigned sum, cnt, mine, sp = 0u;
  for (;;) {
    sum = 0u; cnt = 0u; mine = 0u;
#pragma unroll
    for (unsigned j = 0; j < 16; ++j) { const unsigned c = xb_ld(&bar[XB_XCNT(j)]); sum += c; cnt += (c > 0u) ? 1u : 0u; mine = (j == x) ? c : mine; }
    if (sum == G) break;
    __builtin_amdgcn_s_sleep(1);
    if ((++sp & 255u) == 0u) { if (xb_ld(&bar[XB_TMO])) break; if (sp > XB_SPIN_CAP) { atomicAdd(&bar[XB_TMO], 1u); break; } }
  }
  nloc = mine > 0u ? mine : 1u; nx = cnt > 0u ? cnt : 1u;
}
DI void xcd_barrier(const XcdBarrier& b) {
  asm volatile("s_waitcnt vmcnt(0)" ::: "memory");
  __syncthreads();
  if (threadIdx.x == 0) {
    unsigned* bar = b.bar;
    __builtin_amdgcn_s_waitcnt(0);
    unsigned nloc = b.st[0], nx = b.st[1];
    if (nloc == 0u) { xcd_barrier_complete(bar, b.x, nloc, nx); b.st[0] = nloc; b.st[1] = nx; }
    const unsigned old = xb_add(&bar[XB_XSUB(b.x)], 1u);
    const unsigned gen = old / nloc;
    if (old + 1u == (gen + 1u) * nloc) {
      __builtin_amdgcn_fence(__ATOMIC_RELEASE, "agent");
      asm volatile("s_waitcnt vmcnt(0)" ::: "memory");
      const unsigned og = xb_add(&bar[XB_TOP], 1u);
      const unsigned tg = og / nx;
      if (og + 1u == (tg + 1u) * nx) xb_add(&bar[XB_TOPGEN], 1u);
      else XB_SPIN(xb_ld(&bar[XB_TOPGEN]) == tg, bar);
      __builtin_amdgcn_fence(__ATOMIC_ACQUIRE, "agent");
      xb_add(&bar[XB_XGEN(b.x)], 1u);
      asm volatile("s_waitcnt vmcnt(0)" ::: "memory");
    } else {
      XB_SPIN(xb_ld(&bar[XB_XGEN(b.x)]) == gen, bar);
      __builtin_amdgcn_fence(__ATOMIC_ACQUIRE, "agent");
      asm volatile("s_waitcnt vmcnt(0)" ::: "memory");
    }
  }
  __syncthreads();
}

constexpr int PH_PER_LAYER = 9;
constexpr int N_PHASES = 1 + 4 * PH_PER_LAYER;

DI void run_phase(const Params& p, int ph, char* smem, int rep = 0) {
  if (ph == 0) { phase0(p, smem); return; }
  const int layer = (ph - 1) / PH_PER_LAYER, sub = (ph - 1) % PH_PER_LAYER;
  const int kind = layer % 3, j = layer / 3;
  const bool last = layer == 3;
  const float* modsL = (const float*)(p.ws + OFF_MODS) + (size_t)layer * 5 * 6144;
  const bf16_t* abuf = (const bf16_t*)(p.ws + OFF_ABUF);
  char* mix = p.ws + OFF_MIX;
  switch (sub) {
    case 0:
      phase_norm(p, p.in[6] + layer * DM, modsL, 0, 1, false);
      phase_convert(p, layer);
      break;
    case 1:
      if (kind == 0) { EpiMlaIn e{(float*)(p.ws + MLA_Q)}; gemm_phase<2, false>(abuf, (const bf16_t*)mix, 1024, 3, false, e, smem); }
      else if (kind == 1) { EpiHgIn e{p.ws}; gemm_phase_pref<2, false>(abuf, (const bf16_t*)mix, 1024, 20, false, e, smem); }
      else { EpiDfQkv e{p.ws, p.in[26], p.in[27]}; gemm_phase<2, true>(abuf, (const bf16_t*)mix, 1024, 12, false, e, smem); }
      break;
    case 2:
      if (kind == 0) phase_mla_post(p, j);
      else if (kind == 1) phase_hg_scan(p, smem);
      else phase_attn_df(p, !last, smem);
      break;
    case 3:
      if (kind == 0) {
        EpiMlaUq e1{p.ws, p.in[16] + j * 128, p.in[17] + j * 64};
        gemm_phase<2, true>((const bf16_t*)(p.ws + MLA_CQN), (const bf16_t*)(mix + 1572864), 384, 6, false, e1, smem);
        EpiMlaUkv e2{p.ws, p.in[18] + j * 128};
        gemm_phase<2, true>((const bf16_t*)(p.ws + MLA_CKVN), (const bf16_t*)(mix + 2752512), 256, 8, false, e2, smem);
      } else if (kind == 1) phase_hg_readout(p, j);
      break;
    case 4:
      if (kind == 0) phase_attn_mla(p, !last, smem);
      break;
    case 5: {
      EpiX e{&p, modsL + 2 * 1024, rep ? 0.f : 1.f};
      const bf16_t* wo = (const bf16_t*)(mix + (kind == 0 ? 3801088 : kind == 1 ? 10485760 : 6291456));
      gemm_phase<2, false, 8>(abuf, wo, 1024, 4, last, e, smem);
    } break;
    case 6:
      phase_norm(p, p.in[7] + layer * DM, modsL, 3, 4, last);
      break;
    case 7: {
      EpiFfnUp e{(bf16_t*)(p.ws + FFN_H)};
      gemm_phase_pref<2, false>(abuf, (const bf16_t*)(p.ws + OFF_W13), 1024, 22, last, e, smem);
    } break;
    case 8: {
      EpiX e{&p, modsL + 5 * 1024, rep ? 0.f : 1.f};
      gemm_phase<2, false, 8>((const bf16_t*)(p.ws + FFN_H), (const bf16_t*)(p.ws + OFF_W2), DFF, 4, last, e, smem);
    } break;
  }
}

DI bool phase_empty(int ph) {
  if (ph == 0) return false;
  const int layer = (ph - 1) / PH_PER_LAYER, sub = (ph - 1) % PH_PER_LAYER, kind = layer % 3;
  return (sub == 4 && kind != 0) || (sub == 3 && kind == 2);
}

__global__ void __launch_bounds__(NTHR) mega_kernel(Params p) {
  extern __shared__ __attribute__((aligned(16))) char smem[];
  cg::grid_group grid = cg::this_grid();
#if !MULTI_LAUNCH
  volatile LAS unsigned* st = (volatile LAS unsigned*)(smem + LDS_PHASE);
  if (threadIdx.x == 0) { st[0] = 0u; st[1] = 0u; st[2] = 0u; st[3] = 0u; }
  __syncthreads();
  const XcdBarrier xb = xcd_barrier_post((unsigned*)(p.ws + OFF_BAR), st);
#endif
  for (int ph = p.ph_lo; ph < p.ph_hi; ++ph) {
    if (phase_empty(ph)) continue;
#if PROBE_ON
    const int nrep = (PROBE_SEL(ph)) ? 2 : 1;
    for (int rep = 0; rep < nrep; ++rep) { run_phase(p, ph, smem, rep); if (rep + 1 < nrep) grid.sync(); }
#else
    run_phase(p, ph, smem);
#endif
    if (ph + 1 < p.ph_hi) {
#if MULTI_LAUNCH
      grid.sync();
#else
      if (ph == 0) grid.sync();
      else xcd_barrier(xb);
#endif
    }
  }
}

extern "C" void kernel_launch(void* const* d_in, const int* in_sizes, int n_in, void* d_out, int out_size, void* d_ws, size_t ws_size, hipStream_t stream) {
  static int grid_blocks = 0;
  if (grid_blocks == 0) {
    if (n_in != 31 || ws_size < WS_NEED) { fprintf(stderr, "kernel_launch: unexpected n_in %d / ws_size %zu (need %zu)\n", n_in, ws_size, (size_t)WS_NEED); grid_blocks = -1; return; }
    int dev = 0, cus = 0, per_cu = 0;
    hipGetDevice(&dev);
    hipDeviceGetAttribute(&cus, hipDeviceAttributeMultiprocessorCount, dev);
    if (hipFuncSetAttribute((const void*)mega_kernel, hipFuncAttributeMaxDynamicSharedMemorySize, LDS_BYTES) != hipSuccess) { fprintf(stderr, "hipFuncSetAttribute failed\n"); grid_blocks = -1; return; }
    if (hipOccupancyMaxActiveBlocksPerMultiprocessor(&per_cu, (const void*)mega_kernel, NTHR, LDS_BYTES) != hipSuccess || per_cu < 1) { fprintf(stderr, "occupancy query: %d\n", per_cu); per_cu = 1; }
    (void)hipGetLastError();
    grid_blocks = cus * 1;
    if (grid_blocks % 8 != 0 || grid_blocks < 8) grid_blocks = 256;
  }
  if (grid_blocks < 0) return;
  Params p{};
  for (int i = 0; i < 31; ++i) p.in[i] = (const float*)d_in[i];
  p.out = (float*)d_out; p.ws = (char*)d_ws;
#if MULTI_LAUNCH
  for (int ph = 0; ph < N_PHASES; ++ph) {
    p.ph_lo = ph; p.ph_hi = ph + 1;
    void* args[] = {&p};
    hipError_t e = hipLaunchCooperativeKernel((const void*)mega_kernel, dim3(grid_blocks), dim3(NTHR), args, LDS_BYTES, stream);
    if (e != hipSuccess) { fprintf(stderr, "launch failed: %s\n", hipGetErrorString(e)); break; }
  }
#else
  p.ph_lo = 0; p.ph_hi = N_PHASES;
  if (hipMemsetAsync((char*)d_ws + OFF_BAR, 0, XCD_BAR_WORDS * 4, stream) != hipSuccess) { fprintf(stderr, "memset of barrier words failed\n"); return; }
  void* args[] = {&p};
  hipError_t e = hipLaunchCooperativeKernel((const void*)mega_kernel, dim3(grid_blocks), dim3(NTHR), args, LDS_BYTES, stream);
  if (e != hipSuccess) fprintf(stderr, "cooperative launch failed: %s (grid %d)\n", hipGetErrorString(e), grid_blocks);
#endif
}
```

```cpp
#include <hip/hip_runtime.h>
#include <hip/hip_cooperative_groups.h>
#include <cstdio>
namespace cg = cooperative_groups;

#define DI __device__ __forceinline__
#define PIN() do { asm volatile("" ::: "memory"); __builtin_amdgcn_sched_barrier(0); } while (0)
#ifndef MULTI_LAUNCH
#define MULTI_LAUNCH 0
#endif
#define PROBE_ON 0
#define PROBE_SEL(ph) (((ph) - 1) % 9 == 1 || (ph) == 4 || (ph) == 31 || ((ph) - 1) % 9 == 5 || ((ph) - 1) % 9 == 7 || ((ph) - 1) % 9 == 8)

typedef unsigned short bf16_t;
using bf16x8 = __attribute__((ext_vector_type(8))) short;
using f32x16 = __attribute__((ext_vector_type(16))) float;
#define MFMA(a, b, c) __builtin_amdgcn_mfma_f32_32x32x16_bf16((a), (b), (c), 0, 0, 0)

constexpr int NB = 4, SEQ = 8192, CTXL = 256, PL = 8448, NT = NB * PL, DM = 1024, DFF = 2816;
constexpr int MT = NT / 256;
constexpr int PT = PL / 256;
constexpr int NTHR = 512;
constexpr float EPS = 1e-6f;

constexpr size_t OFF_W13 = 0;
constexpr size_t OFF_W2 = 11534336;
constexpr size_t OFF_MIX = 17301504;
constexpr size_t OFF_MODS = 33554432;
constexpr size_t OFF_LB = OFF_MODS + 524288;
constexpr size_t OFF_LAM = OFF_MODS + 540672;
constexpr size_t OFF_COS = OFF_MODS + 544768;
constexpr size_t OFF_SIN = OFF_MODS + 552960;
constexpr size_t OFF_BAR = OFF_MODS + 589824;
constexpr size_t OFF_CTXX = 34603008;
constexpr size_t OFF_ABUF = 38797312;
constexpr size_t OFF_SCR = 108003328;
constexpr size_t ACT16 = (size_t)NT * DM * 2;
constexpr size_t WS_NEED = OFF_SCR + 6 * ACT16;
constexpr size_t MLA_Q = OFF_SCR;
constexpr size_t MLA_K = MLA_Q + (size_t)NT * 8 * 192 * 2;
constexpr size_t MLA_VT = MLA_K + (size_t)NT * 8 * 192 * 2;
constexpr size_t MLA_CQN = MLA_VT + ACT16;
constexpr size_t MLA_CKVN = MLA_CQN + (size_t)NT * 384 * 2;
constexpr size_t HG_Q = OFF_SCR, HG_KF = HG_Q + ACT16, HG_KB = HG_KF + ACT16, HG_I = HG_KB + ACT16, HG_G = HG_I + ACT16, HG_OB = HG_G + ACT16;
constexpr size_t DF_Q = OFF_SCR, DF_K = DF_Q + ACT16, DF_VT = DF_K + ACT16;
constexpr size_t FFN_H = OFF_SCR;

constexpr int LDS_PHASE = 147456;
constexpr int LDS_BYTES = LDS_PHASE + 16;

struct Params {
  const float* in[31];
  float* out;
  char* ws;
  int ph_lo, ph_hi;
};

DI int TID() { int t = threadIdx.x; asm volatile("" : "+v"(t)); return t; }
DI int BID() { int t = blockIdx.x; asm volatile("" : "+s"(t)); return t; }
DI float bf2f(unsigned short v) { return __uint_as_float(((unsigned)v) << 16); }
typedef float f32x2_t __attribute__((ext_vector_type(2)));
typedef __bf16 bf16x2_t __attribute__((ext_vector_type(2)));
DI unsigned pk2(float a, float b) { f32x2_t v = {a, b}; bf16x2_t r = __builtin_convertvector(v, bf16x2_t); return __builtin_bit_cast(unsigned, r); }
DI unsigned short f2bf(float x) { return (unsigned short)(pk2(x, 0.f) & 0xffffu); }
DI float sigmf(float x) { return __builtin_amdgcn_rcpf(1.f + __builtin_amdgcn_exp2f(-1.4426950408889634f * x)); }
DI float siluf(float x) { return x * sigmf(x); }
DI int crow(int i, int h) { return (i & 3) + 8 * (i >> 2) + 4 * h; }
DI float half_sum(float v) {
  const auto rr = __builtin_amdgcn_permlane32_swap(__float_as_uint(v), __float_as_uint(v), false, false);
  return __uint_as_float(rr[0]) + __uint_as_float(rr[1]);
}
DI float wave_sum(float v) {
#pragma unroll
  for (int o = 32; o > 0; o >>= 1) v += __shfl_xor(v, o);
  return v;
}
DI float* xrow(const Params& p, int r) {
  int b = r / PL, pp = r - b * PL;
  return pp < CTXL ? (float*)(p.ws + OFF_CTXX) + (size_t)(b * CTXL + pp) * DM : p.out + (size_t)(b * SEQ + pp - CTXL) * DM;
}

DI void phase0(const Params& p, char* smem) {
  const int tid = TID(), lane = tid & 63, wv = tid >> 6;
  const size_t gsz = (size_t)gridDim.x * NTHR, gid = (size_t)BID() * NTHR + tid;
  {
    const float4* xs = (const float4*)p.in[0]; float4* xd = (float4*)p.out;
    for (size_t i = gid; i < (size_t)NB * SEQ * DM / 4; i += gsz) xd[i] = xs[i];
    const float4* cs = (const float4*)p.in[2]; float4* cd = (float4*)(p.ws + OFF_CTXX);
    for (size_t i = gid; i < (size_t)NB * CTXL * DM / 4; i += gsz) cd[i] = cs[i];
  }
  if (gid < 2048) {
    int pos = (int)gid >> 4, j = (int)gid & 15;
    float invf = powf(10000.f, -(float)(2 * j) / 32.f);
    float ang = (float)pos * invf;
    ((float*)(p.ws + OFF_COS))[gid] = cosf(ang);
    ((float*)(p.ws + OFF_SIN))[gid] = sinf(ang);
  }
  if (gid >= 2048 && gid < 4096) {
    int d = (int)gid - 2048;
    const float* lg = p.in[22];
    float l0 = lg[d], l1 = lg[2048 + d], l2 = lg[4096 + d], l3 = lg[6144 + d];
    float mx = fmaxf(fmaxf(l0, l1), fmaxf(l2, l3));
    float e0 = expf(l0 - mx), e1 = expf(l1 - mx), e2 = expf(l2 - mx), e3 = expf(l3 - mx);
    ((float*)(p.ws + OFF_LB))[d] = e1 / (e0 + e1 + e2 + e3);
  }
  if (gid == 4096) {
    const float* lv = p.in[28];
    float s01 = 0.f, s23 = 0.f;
    for (int j = 0; j < 64; ++j) { s01 += lv[j] * lv[64 + j]; s23 += lv[128 + j] * lv[192 + j]; }
    float lam_init = 0.8f - 0.6f * expf(-0.3f * 2.f);
    ((float*)(p.ws + OFF_LAM))[0] = expf(s01) - expf(s23) + lam_init;
  }
  float* sS = (float*)smem;
  float* red = sS + 5 * 1024;
  for (int i = tid; i < 5 * 1024; i += NTHR) {
    int r = i >> 10, k = i & 1023;
    float c = r < 4 ? p.in[1][r * 1024 + k] : p.in[3][k];
    sS[i] = siluf(c);
  }
  __syncthreads();
  float* mods = (float*)(p.ws + OFF_MODS);
  for (int job = BID(); job < 4 * 96; job += gridDim.x) {
    int li = job / 96, cgp = job % 96, n = cgp * 64 + lane;
    const float* W = p.in[4] + ((size_t)li * 1024 + wv * 128) * 6144 + n;
    float a0 = 0, a1 = 0, a2 = 0, a3 = 0, a4 = 0;
#pragma unroll 4
    for (int k = 0; k < 128; ++k) {
      float w = W[(size_t)k * 6144];
      int kk = wv * 128 + k;
      a0 += sS[kk] * w; a1 += sS[1024 + kk] * w; a2 += sS[2048 + kk] * w; a3 += sS[3072 + kk] * w; a4 += sS[4096 + kk] * w;
    }
    red[(wv * 5 + 0) * 64 + lane] = a0; red[(wv * 5 + 1) * 64 + lane] = a1; red[(wv * 5 + 2) * 64 + lane] = a2;
    red[(wv * 5 + 3) * 64 + lane] = a3; red[(wv * 5 + 4) * 64 + lane] = a4;
    __syncthreads();
    if (tid < 320) {
      int r = tid >> 6, l = tid & 63;
      float s = 0.f;
#pragma unroll
      for (int w = 0; w < 8; ++w) s += red[(w * 5 + r) * 64 + l];
      int nn = cgp * 64 + l;
      mods[(size_t)(li * 5 + r) * 6144 + nn] = s + p.in[5][li * 6144 + nn];
    }
    __syncthreads();
  }
}

DI void convert_w(const float* src, const float* src2, int srcN, int K, bf16_t* dst, int Nd, int mode) {
  const size_t gsz = (size_t)gridDim.x * NTHR, gid = (size_t)BID() * NTHR + TID();
  const size_t total = (size_t)Nd * (K >> 3);
  for (size_t e = gid; e < total; e += gsz) {
    int nd = (int)(e % Nd), k0 = (int)(e / Nd) * 8;
    const float* s = src; int col = nd; bool valid = true;
    if (mode == 0) { valid = nd < srcN; }
    else if (mode == 1) { int g = nd >> 6, w = nd & 63; if (w < 32) col = g * 32 + w; else { s = src2; col = g * 32 + w - 32; } }
    else { if (nd < 1024) col = (nd >> 7) * 192 + (nd & 127); else { int r = nd - 1024; col = (r >> 6) * 192 + 128 + (r & 63); } }
    float v[8];
#pragma unroll
    for (int j = 0; j < 8; ++j) v[j] = valid ? s[(size_t)(k0 + j) * srcN + col] : 0.f;
    uint4 o; o.x = pk2(v[0], v[1]); o.y = pk2(v[2], v[3]); o.z = pk2(v[4], v[5]); o.w = pk2(v[6], v[7]);
    *(uint4*)(dst + (size_t)nd * K + k0) = o;
  }
}

DI void phase_convert(const Params& p, int layer) {
  const int kind = layer % 3, j = layer / 3;
  convert_w(p.in[8] + (size_t)layer * DM * DFF, p.in[9] + (size_t)layer * DM * DFF, DFF, DM, (bf16_t*)(p.ws + OFF_W13), 2 * DFF, 1);
  convert_w(p.in[10] + (size_t)layer * DFF * DM, nullptr, DM, DFF, (bf16_t*)(p.ws + OFF_W2), DM, 0);
  char* mix = p.ws + OFF_MIX;
  if (kind == 0) {
    convert_w(p.in[11] + (size_t)j * 1024 * 704, nullptr, 704, 1024, (bf16_t*)(mix), 768, 0);
    convert_w(p.in[14] + (size_t)j * 384 * 1536, nullptr, 1536, 384, (bf16_t*)(mix + 1572864), 1536, 2);
    convert_w(p.in[15] + (size_t)j * 256 * 2048, nullptr, 2048, 256, (bf16_t*)(mix + 2752512), 2048, 0);
    convert_w(p.in[20] + (size_t)j * 1024 * 1024, nullptr, 1024, 1024, (bf16_t*)(mix + 3801088), 1024, 0);
  } else if (kind == 1) {
    convert_w(p.in[21] + (size_t)j * 1024 * 5120, nullptr, 5120, 1024, (bf16_t*)(mix), 5120, 0);
    convert_w(p.in[24] + (size_t)j * 1024 * 1024, nullptr, 1024, 1024, (bf16_t*)(mix + 10485760), 1024, 0);
  } else {
    convert_w(p.in[25] + (size_t)j * 1024 * 3072, nullptr, 3072, 1024, (bf16_t*)(mix), 3072, 0);
    convert_w(p.in[30] + (size_t)j * 1024 * 1024, nullptr, 1024, 1024, (bf16_t*)(mix + 6291456), 1024, 0);
  }
}

DI void phase_norm(const Params& p, const float* nw, const float* modsL, int selShift, int selScale, bool skipctx) {
  const int lane = TID() & 63, wv = TID() >> 6;
  bf16_t* abuf = (bf16_t*)(p.ws + OFF_ABUF);
  const int stride = gridDim.x * 8;
  int r = BID() * 8 + wv;
  float4 w[4];
#pragma unroll
  for (int q = 0; q < 4; ++q) w[q] = *(const float4*)(nw + (lane + 64 * q) * 4);
  float4 v[4], vn[4];
  if (r < NT) {
    const float4* x = (const float4*)xrow(p, r);
#pragma unroll
    for (int q = 0; q < 4; ++q) v[q] = x[lane + 64 * q];
  }
  for (; r < NT; r += stride) {
    const int rn = r + stride;
    if (rn < NT) {
      const float4* xn = (const float4*)xrow(p, rn);
#pragma unroll
      for (int q = 0; q < 4; ++q) vn[q] = xn[lane + 64 * q];
    }
    const int b = r / PL, pp = r - b * PL;
    const bool isctx = pp < CTXL;
    if (!(skipctx && isctx)) {
      const float* md = modsL + (size_t)(isctx ? 4 : b) * 6144;
      float ss = 0.f;
#pragma unroll
      for (int q = 0; q < 4; ++q) ss += v[q].x * v[q].x + v[q].y * v[q].y + v[q].z * v[q].z + v[q].w * v[q].w;
      ss = wave_sum(ss);
      const float rs = rsqrtf(ss * (1.f / 1024.f) + EPS);
#pragma unroll
      for (int q = 0; q < 4; ++q) {
        const int k0 = (lane + 64 * q) * 4;
        const float4 sc = *(const float4*)(md + selScale * 1024 + k0), sh = *(const float4*)(md + selShift * 1024 + k0);
        const float a0 = v[q].x * rs * w[q].x * (1.f + sc.x) + sh.x, a1 = v[q].y * rs * w[q].y * (1.f + sc.y) + sh.y;
        const float a2 = v[q].z * rs * w[q].z * (1.f + sc.z) + sh.z, a3 = v[q].w * rs * w[q].w * (1.f + sc.w) + sh.w;
        uint2 o; o.x = pk2(a0, a1); o.y = pk2(a2, a3);
        *(uint2*)(abuf + (size_t)r * DM + k0) = o;
      }
    }
#pragma unroll
    for (int q = 0; q < 4; ++q) v[q] = vn[q];
  }
}

constexpr int GSTR = 144;

template <int WM, bool SWAP, int NSPLIT = 0, class Epi>
DI void gemm_phase(const bf16_t* A, const bf16_t* W, int K, int ntiles, bool skipctx, const Epi& epi, char* smem) {
  constexpr int BN = 128 * WM, GBUF = (256 + BN) * GSTR;
  const int tid = TID(), lane = tid & 63, wv = tid >> 6, l31 = lane & 31, hh = lane >> 5;
  const int wm = (WM == 1) ? wv : (wv & 3), wn = (WM == 1) ? 0 : (wv >> 2);
  const int xcd = BID() & 7, slot = BID() >> 3, nslots = gridDim.x >> 3;
  const int nk = K >> 6;
  const int tiles_x = ((MT - xcd + 7) >> 3) * ntiles;
  constexpr int NSP = NSPLIT > 0 ? NSPLIT : 1;
  const int full = NSPLIT > 0 ? (tiles_x / nslots) * nslots : tiles_x;
  const int nunits = full + (tiles_x - full) * NSP;
  for (int u = slot; u < nunits; u += nslots) {
    const bool part = u >= full;
    const int q = part ? full + (u - full) / NSP : u, ks = part ? (u - full) % NSP : 0;
    const int mtl = q / ntiles, nt = q - mtl * ntiles, mt = mtl * 8 + xcd;
    if (skipctx && (mt % PT) == 0) continue;
    const int kt0 = part ? (ks * nk) / NSP : 0, kt1 = part ? ((ks + 1) * nk) / NSP : nk;
    const bf16_t* Ag = A + (size_t)mt * 256 * K;
    const bf16_t* Wg = W + (size_t)nt * BN * K;
    f32x16 acc[WM][4];
#pragma unroll
    for (int mi = 0; mi < WM; ++mi)
#pragma unroll
      for (int nb = 0; nb < 4; ++nb)
#pragma unroll
        for (int i = 0; i < 16; ++i) acc[mi][nb][i] = 0.f;
    uint4 ra0, ra1, ra2, ra3, rw0, rw1, rw2, rw3;
    rw2 = make_uint4(0, 0, 0, 0); rw3 = rw2;
    const int grow = tid >> 3, gcol = (tid & 7) * 8;
    const bf16_t* ap = Ag + (size_t)grow * K + gcol;
    const bf16_t* wp = Wg + (size_t)grow * K + gcol;
    const int lo = grow * GSTR + (tid & 7) * 16;
#define GLOADG(kt_) do { const int ko_ = (kt_) * 64; \
      ra0 = *(const uint4*)(ap + ko_); ra1 = *(const uint4*)(ap + (size_t)64 * K + ko_); ra2 = *(const uint4*)(ap + (size_t)128 * K + ko_); ra3 = *(const uint4*)(ap + (size_t)192 * K + ko_); \
      rw0 = *(const uint4*)(wp + ko_); rw1 = *(const uint4*)(wp + (size_t)64 * K + ko_); \
      if (WM == 2) { rw2 = *(const uint4*)(wp + (size_t)128 * K + ko_); rw3 = *(const uint4*)(wp + (size_t)192 * K + ko_); } } while (0)
#define SSTOREG(buf_) do { char* b_ = (buf_) + lo; \
      *(uint4*)(b_) = ra0; *(uint4*)(b_ + 64 * GSTR) = ra1; *(uint4*)(b_ + 128 * GSTR) = ra2; *(uint4*)(b_ + 192 * GSTR) = ra3; \
      *(uint4*)(b_ + 256 * GSTR) = rw0; *(uint4*)(b_ + 320 * GSTR) = rw1; \
      if (WM == 2) { *(uint4*)(b_ + 384 * GSTR) = rw2; *(uint4*)(b_ + 448 * GSTR) = rw3; } } while (0)
    GLOADG(kt0); SSTOREG(smem);
    if (WM == 2) GLOADG(kt0 + 1 < kt1 ? kt0 + 1 : kt0);
    __syncthreads();
    for (int kt = kt0; kt < kt1; ++kt) {
      const char* cur = smem + ((kt - kt0) & 1) * GBUF;
      if (WM == 1) { GLOADG(kt + 1 < kt1 ? kt + 1 : kt); PIN(); }
      const char* ab = cur + (wm * 32 * WM + l31) * GSTR + hh * 16;
      const char* wb = cur + (256 + wn * 128 + l31) * GSTR + hh * 16;
      bf16x8 tfA, tfA1, tfB, tfB1, wfA0, wfA1, wfA2, wfA3, wfB0, wfB1, wfB2, wfB3;
#define LDFR(tf_, tf1_, w0_, w1_, w2_, w3_, s_) do { tf_ = *(const bf16x8*)(ab + (s_) * 32); if (WM == 2) tf1_ = *(const bf16x8*)(ab + 32 * GSTR + (s_) * 32); \
        w0_ = *(const bf16x8*)(wb + (s_) * 32); w1_ = *(const bf16x8*)(wb + 32 * GSTR + (s_) * 32); \
        w2_ = *(const bf16x8*)(wb + 64 * GSTR + (s_) * 32); w3_ = *(const bf16x8*)(wb + 96 * GSTR + (s_) * 32); } while (0)
#define DOMM1(mi_, tf_, w0_, w1_, w2_, w3_) do { if (SWAP) { acc[mi_][0] = MFMA(w0_, tf_, acc[mi_][0]); acc[mi_][1] = MFMA(w1_, tf_, acc[mi_][1]); acc[mi_][2] = MFMA(w2_, tf_, acc[mi_][2]); acc[mi_][3] = MFMA(w3_, tf_, acc[mi_][3]); } \
        else { acc[mi_][0] = MFMA(tf_, w0_, acc[mi_][0]); acc[mi_][1] = MFMA(tf_, w1_, acc[mi_][1]); acc[mi_][2] = MFMA(tf_, w2_, acc[mi_][2]); acc[mi_][3] = MFMA(tf_, w3_, acc[mi_][3]); } } while (0)
#define DOMM(tf_, tf1_, w0_, w1_, w2_, w3_) do { DOMM1(0, tf_, w0_, w1_, w2_, w3_); if (WM == 2) DOMM1(WM - 1, tf1_, w0_, w1_, w2_, w3_); } while (0)
      if (WM == 1) {
        LDFR(tfA, tfA1, wfA0, wfA1, wfA2, wfA3, 0);
        LDFR(tfB, tfB1, wfB0, wfB1, wfB2, wfB3, 1);
        PIN();
        DOMM(tfA, tfA1, wfA0, wfA1, wfA2, wfA3);
        PIN();
        LDFR(tfA, tfA1, wfA0, wfA1, wfA2, wfA3, 2);
        PIN();
        DOMM(tfB, tfB1, wfB0, wfB1, wfB2, wfB3);
        PIN();
        LDFR(tfB, tfB1, wfB0, wfB1, wfB2, wfB3, 3);
        PIN();
        DOMM(tfA, tfA1, wfA0, wfA1, wfA2, wfA3);
        DOMM(tfB, tfB1, wfB0, wfB1, wfB2, wfB3);
      } else {
        char* nb_ = smem + ((kt + 1 - kt0) & 1) * GBUF + lo;
#define MM2(mi_, tf_, wa_, wb_, na_, nb2_) do { if (SWAP) { acc[mi_][na_] = MFMA(wa_, tf_, acc[mi_][na_]); acc[mi_][nb2_] = MFMA(wb_, tf_, acc[mi_][nb2_]); } \
          else { acc[mi_][na_] = MFMA(tf_, wa_, acc[mi_][na_]); acc[mi_][nb2_] = MFMA(tf_, wb_, acc[mi_][nb2_]); } } while (0)
        LDFR(tfA, tfA1, wfA0, wfA1, wfA2, wfA3, 0);
        PIN();
        DOMM(tfA, tfA1, wfA0, wfA1, wfA2, wfA3);
        PIN();
        LDFR(tfA, tfA1, wfA0, wfA1, wfA2, wfA3, 1);
        PIN();
        DOMM(tfA, tfA1, wfA0, wfA1, wfA2, wfA3);
        PIN();
        LDFR(tfA, tfA1, wfA0, wfA1, wfA2, wfA3, 2);
        PIN();
        MM2(0, tfA, wfA0, wfA1, 0, 1); PIN(); *(uint4*)(nb_) = ra0; PIN();
        MM2(0, tfA, wfA2, wfA3, 2, 3); PIN(); *(uint4*)(nb_ + 64 * GSTR) = ra1; PIN();
        MM2(1, tfA1, wfA0, wfA1, 0, 1); PIN(); *(uint4*)(nb_ + 128 * GSTR) = ra2; PIN();
        MM2(1, tfA1, wfA2, wfA3, 2, 3); PIN(); *(uint4*)(nb_ + 192 * GSTR) = ra3; PIN();
        LDFR(tfA, tfA1, wfA0, wfA1, wfA2, wfA3, 3);
        PIN();
        MM2(0, tfA, wfA0, wfA1, 0, 1); PIN(); *(uint4*)(nb_ + 256 * GSTR) = rw0; PIN();
        MM2(0, tfA, wfA2, wfA3, 2, 3); PIN(); *(uint4*)(nb_ + 320 * GSTR) = rw1; PIN();
        MM2(1, tfA1, wfA0, wfA1, 0, 1); PIN(); *(uint4*)(nb_ + 384 * GSTR) = rw2; PIN();
        MM2(1, tfA1, wfA2, wfA3, 2, 3); PIN(); *(uint4*)(nb_ + 448 * GSTR) = rw3; PIN();
        GLOADG(kt + 2 < kt1 ? kt + 2 : kt);
#undef MM2
      }
#undef LDFR
#undef DOMM
#undef DOMM1
      PIN();
      if (WM == 1) { if (kt + 1 < kt1) SSTOREG(smem + ((kt + 1 - kt0) & 1) * GBUF); }
      __syncthreads();
    }
#pragma unroll
    for (int mi = 0; mi < WM; ++mi) epi(acc[mi], __builtin_amdgcn_readfirstlane(mt * 256 + (wm * WM + mi) * 32), __builtin_amdgcn_readfirstlane(nt * WM + wn), lane, part);
  }
#undef GLOADG
#undef SSTOREG
}

template <int WM, bool SWAP, int NSPLIT = 0, class Epi>
DI void gemm_phase_pref(const bf16_t* A, const bf16_t* W, int K, int ntiles, bool skipctx, const Epi& epi, char* smem) {
  constexpr int BN = 128 * WM, GBUF = (256 + BN) * GSTR;
  const int tid = TID(), lane = tid & 63, wv = tid >> 6, l31 = lane & 31, hh = lane >> 5;
  const int wm = (WM == 1) ? wv : (wv & 3), wn = (WM == 1) ? 0 : (wv >> 2);
  const int xcd = BID() & 7, slot = BID() >> 3, nslots = gridDim.x >> 3;
  const int nk = K >> 6;
  const int tiles_x = ((MT - xcd + 7) >> 3) * ntiles;
  constexpr int NSP = NSPLIT > 0 ? NSPLIT : 1;
  const int full = NSPLIT > 0 ? (tiles_x / nslots) * nslots : tiles_x;
  const int nunits = full + (tiles_x - full) * NSP;
  uint4 ra0, ra1, ra2, ra3, rw0, rw1, rw2, rw3;
  rw2 = make_uint4(0, 0, 0, 0); rw3 = rw2;
  const int grow = tid >> 3, gcol = (tid & 7) * 8;
  const int lo = grow * GSTR + (tid & 7) * 16;
  const bf16_t* ap = A; const bf16_t* wp = W;
#define GLOADG(kt_) do { const int ko_ = (kt_) * 64; \
      ra0 = *(const uint4*)(ap + ko_); ra1 = *(const uint4*)(ap + (size_t)64 * K + ko_); ra2 = *(const uint4*)(ap + (size_t)128 * K + ko_); ra3 = *(const uint4*)(ap + (size_t)192 * K + ko_); \
      rw0 = *(const uint4*)(wp + ko_); rw1 = *(const uint4*)(wp + (size_t)64 * K + ko_); \
      if (WM == 2) { rw2 = *(const uint4*)(wp + (size_t)128 * K + ko_); rw3 = *(const uint4*)(wp + (size_t)192 * K + ko_); } } while (0)
#define SSTOREG(buf_) do { char* b_ = (buf_) + lo; \
      *(uint4*)(b_) = ra0; *(uint4*)(b_ + 64 * GSTR) = ra1; *(uint4*)(b_ + 128 * GSTR) = ra2; *(uint4*)(b_ + 192 * GSTR) = ra3; \
      *(uint4*)(b_ + 256 * GSTR) = rw0; *(uint4*)(b_ + 320 * GSTR) = rw1; \
      if (WM == 2) { *(uint4*)(b_ + 384 * GSTR) = rw2; *(uint4*)(b_ + 448 * GSTR) = rw3; } } while (0)
#define UNIT_DECODE(u_, mt_, nt_, kt0_, kt1_, part_) do { part_ = (u_) >= full; \
      const int q_ = part_ ? full + ((u_) - full) / NSP : (u_), ks_ = part_ ? ((u_) - full) % NSP : 0; \
      const int mtl_ = q_ / ntiles; nt_ = q_ - mtl_ * ntiles; mt_ = mtl_ * 8 + xcd; \
      kt0_ = part_ ? (ks_ * nk) / NSP : 0; kt1_ = part_ ? ((ks_ + 1) * nk) / NSP : nk; } while (0)
  int u = slot, mt = 0, nt = 0, kt0 = 0, kt1 = 0; bool part = false;
  for (; u < nunits; u += nslots) { UNIT_DECODE(u, mt, nt, kt0, kt1, part); if (!(skipctx && (mt % PT) == 0)) break; }
  if (u < nunits) { ap = A + (size_t)mt * 256 * K + (size_t)grow * K + gcol; wp = W + (size_t)nt * BN * K + (size_t)grow * K + gcol; GLOADG(kt0); }
  while (u < nunits) {
    f32x16 acc[WM][4];
#pragma unroll
    for (int mi = 0; mi < WM; ++mi)
#pragma unroll
      for (int nb = 0; nb < 4; ++nb)
#pragma unroll
        for (int i = 0; i < 16; ++i) acc[mi][nb][i] = 0.f;
    SSTOREG(smem);
    if (WM == 2) GLOADG(kt0 + 1 < kt1 ? kt0 + 1 : kt0);
    __syncthreads();
    for (int kt = kt0; kt < kt1; ++kt) {
      const char* cur = smem + ((kt - kt0) & 1) * GBUF;
      if (WM == 1) { GLOADG(kt + 1 < kt1 ? kt + 1 : kt); PIN(); }
      const char* ab = cur + (wm * 32 * WM + l31) * GSTR + hh * 16;
      const char* wb = cur + (256 + wn * 128 + l31) * GSTR + hh * 16;
      bf16x8 tfA, tfA1, tfB, tfB1, wfA0, wfA1, wfA2, wfA3, wfB0, wfB1, wfB2, wfB3;
#define LDFR(tf_, tf1_, w0_, w1_, w2_, w3_, s_) do { tf_ = *(const bf16x8*)(ab + (s_) * 32); if (WM == 2) tf1_ = *(const bf16x8*)(ab + 32 * GSTR + (s_) * 32); \
        w0_ = *(const bf16x8*)(wb + (s_) * 32); w1_ = *(const bf16x8*)(wb + 32 * GSTR + (s_) * 32); \
        w2_ = *(const bf16x8*)(wb + 64 * GSTR + (s_) * 32); w3_ = *(const bf16x8*)(wb + 96 * GSTR + (s_) * 32); } while (0)
#define DOMM1(mi_, tf_, w0_, w1_, w2_, w3_) do { if (SWAP) { acc[mi_][0] = MFMA(w0_, tf_, acc[mi_][0]); acc[mi_][1] = MFMA(w1_, tf_, acc[mi_][1]); acc[mi_][2] = MFMA(w2_, tf_, acc[mi_][2]); acc[mi_][3] = MFMA(w3_, tf_, acc[mi_][3]); } \
        else { acc[mi_][0] = MFMA(tf_, w0_, acc[mi_][0]); acc[mi_][1] = MFMA(tf_, w1_, acc[mi_][1]); acc[mi_][2] = MFMA(tf_, w2_, acc[mi_][2]); acc[mi_][3] = MFMA(tf_, w3_, acc[mi_][3]); } } while (0)
#define DOMM(tf_, tf1_, w0_, w1_, w2_, w3_) do { DOMM1(0, tf_, w0_, w1_, w2_, w3_); if (WM == 2) DOMM1(WM - 1, tf1_, w0_, w1_, w2_, w3_); } while (0)
      if (WM == 1) {
        LDFR(tfA, tfA1, wfA0, wfA1, wfA2, wfA3, 0);
        LDFR(tfB, tfB1, wfB0, wfB1, wfB2, wfB3, 1);
        PIN();
        DOMM(tfA, tfA1, wfA0, wfA1, wfA2, wfA3);
        PIN();
        LDFR(tfA, tfA1, wfA0, wfA1, wfA2, wfA3, 2);
        PIN();
        DOMM(tfB, tfB1, wfB0, wfB1, wfB2, wfB3);
        PIN();
        LDFR(tfB, tfB1, wfB0, wfB1, wfB2, wfB3, 3);
        PIN();
        DOMM(tfA, tfA1, wfA0, wfA1, wfA2, wfA3);
        DOMM(tfB, tfB1, wfB0, wfB1, wfB2, wfB3);
      } else {
        char* nb_ = smem + ((kt + 1 - kt0) & 1) * GBUF + lo;
#define MM2(mi_, tf_, wa_, wb_, na_, nb2_) do { if (SWAP) { acc[mi_][na_] = MFMA(wa_, tf_, acc[mi_][na_]); acc[mi_][nb2_] = MFMA(wb_, tf_, acc[mi_][nb2_]); } \
          else { acc[mi_][na_] = MFMA(tf_, wa_, acc[mi_][na_]); acc[mi_][nb2_] = MFMA(tf_, wb_, acc[mi_][nb2_]); } } while (0)
        LDFR(tfA, tfA1, wfA0, wfA1, wfA2, wfA3, 0);
        PIN();
        DOMM(tfA, tfA1, wfA0, wfA1, wfA2, wfA3);
        PIN();
        LDFR(tfA, tfA1, wfA0, wfA1, wfA2, wfA3, 1);
        PIN();
        DOMM(tfA, tfA1, wfA0, wfA1, wfA2, wfA3);
        PIN();
        LDFR(tfA, tfA1, wfA0, wfA1, wfA2, wfA3, 2);
        PIN();
        MM2(0, tfA, wfA0, wfA1, 0, 1); PIN(); *(uint4*)(nb_) = ra0; PIN();
        MM2(0, tfA, wfA2, wfA3, 2, 3); PIN(); *(uint4*)(nb_ + 64 * GSTR) = ra1; PIN();
        MM2(1, tfA1, wfA0, wfA1, 0, 1); PIN(); *(uint4*)(nb_ + 128 * GSTR) = ra2; PIN();
        MM2(1, tfA1, wfA2, wfA3, 2, 3); PIN(); *(uint4*)(nb_ + 192 * GSTR) = ra3; PIN();
        LDFR(tfA, tfA1, wfA0, wfA1, wfA2, wfA3, 3);
        PIN();
        MM2(0, tfA, wfA0, wfA1, 0, 1); PIN(); *(uint4*)(nb_ + 256 * GSTR) = rw0; PIN();
        MM2(0, tfA, wfA2, wfA3, 2, 3); PIN(); *(uint4*)(nb_ + 320 * GSTR) = rw1; PIN();
        MM2(1, tfA1, wfA0, wfA1, 0, 1); PIN(); *(uint4*)(nb_ + 384 * GSTR) = rw2; PIN();
        MM2(1, tfA1, wfA2, wfA3, 2, 3); PIN(); *(uint4*)(nb_ + 448 * GSTR) = rw3; PIN();
        GLOADG(kt + 2 < kt1 ? kt + 2 : kt);
#undef MM2
      }
#undef LDFR
#undef DOMM
#undef DOMM1
      PIN();
      if (WM == 1) { if (kt + 1 < kt1) SSTOREG(smem + ((kt + 1 - kt0) & 1) * GBUF); }
      __syncthreads();
    }
    const int cmt = mt, cnt = nt; const bool cpart = part;
    for (u += nslots; u < nunits; u += nslots) { UNIT_DECODE(u, mt, nt, kt0, kt1, part); if (!(skipctx && (mt % PT) == 0)) break; }
    if (u < nunits) { ap = A + (size_t)mt * 256 * K + (size_t)grow * K + gcol; wp = W + (size_t)nt * BN * K + (size_t)grow * K + gcol; GLOADG(kt0); }
    PIN();
#pragma unroll
    for (int mi = 0; mi < WM; ++mi) epi(acc[mi], __builtin_amdgcn_readfirstlane(cmt * 256 + (wm * WM + mi) * 32), __builtin_amdgcn_readfirstlane(cnt * WM + wn), lane, cpart);
  }
#undef GLOADG
#undef SSTOREG
#undef UNIT_DECODE
}

struct EpiX {
  const Params* p; const float* gate; float sc;
  DI void operator()(f32x16 (&acc)[4], int tok0, int nt, int lane, bool part = false) const {
    const int l31 = lane & 31, hh = lane >> 5;
    const int b = tok0 / PL, pp0 = tok0 - b * PL;
    const float* g = gate + (size_t)(pp0 < CTXL ? 4 : b) * 6144;
    float* xb = pp0 < CTXL ? (float*)(p->ws + OFF_CTXX) + (size_t)(b * CTXL + pp0) * DM : p->out + (size_t)(b * SEQ + pp0 - CTXL) * DM;
    float gv[4];
#pragma unroll
    for (int nb = 0; nb < 4; ++nb) gv[nb] = g[nt * 128 + nb * 32 + l31] * sc;
    float* xc = xb + nt * 128;
    const int loff = l31 + hh * 4 * DM;
    if (part) {
#pragma unroll
      for (int nb = 0; nb < 4; ++nb)
#pragma unroll
        for (int i = 0; i < 16; ++i) (void)__hip_atomic_fetch_add(xc + ((i & 3) + 8 * (i >> 2)) * DM + nb * 32 + loff, gv[nb] * acc[nb][i], __ATOMIC_RELAXED, __HIP_MEMORY_SCOPE_AGENT);
    } else {
      float xa[16], xb2[16];
#define XLD(dst_, nb_) _Pragma("unroll") for (int i = 0; i < 16; ++i) dst_[i] = (xc + ((i & 3) + 8 * (i >> 2)) * DM + (nb_) * 32)[loff]
#define XST(src_, nb_) _Pragma("unroll") for (int i = 0; i < 16; ++i) (xc + ((i & 3) + 8 * (i >> 2)) * DM + (nb_) * 32)[loff] = src_[i] + gv[nb_] * acc[nb_][i]
      XLD(xa, 0); XLD(xb2, 1); PIN();
      XST(xa, 0); PIN(); XLD(xa, 2); PIN();
      XST(xb2, 1); PIN(); XLD(xb2, 3); PIN();
      XST(xa, 2); PIN();
      XST(xb2, 3);
#undef XLD
#undef XST
    }
  }
};
struct EpiFfnUp {
  bf16_t* h;
  DI void operator()(f32x16 (&acc)[4], int tok0, int nt, int lane, bool part = false) const {
    const int l31 = lane & 31, hh = lane >> 5;
#pragma unroll
    for (int gg = 0; gg < 2; ++gg) {
      int col = (nt * 2 + gg) * 32 + l31;
#pragma unroll
      for (int i = 0; i < 16; ++i) {
        int row = tok0 + crow(i, hh);
        h[(size_t)row * DFF + col] = f2bf(siluf(acc[2 * gg][i]) * acc[2 * gg + 1][i]);
      }
    }
  }
};
struct EpiMlaIn {
  float* raw;
  DI void operator()(f32x16 (&acc)[4], int tok0, int nt, int lane, bool part = false) const {
    const int l31 = lane & 31, hh = lane >> 5;
#pragma unroll
    for (int nb = 0; nb < 4; ++nb) {
      int col = nt * 128 + nb * 32 + l31;
      if (col < 704) {
#pragma unroll
        for (int i = 0; i < 16; ++i) raw[(size_t)(tok0 + crow(i, hh)) * 704 + col] = acc[nb][i];
      }
    }
  }
};
struct EpiHgIn {
  char* ws;
  DI void operator()(f32x16 (&acc)[4], int tok0, int nt, int lane, bool part = false) const {
    const int l31 = lane & 31, hh = lane >> 5;
    const int sec = nt >> 3;
    bf16_t* dst = (bf16_t*)(ws + HG_Q + (size_t)sec * ACT16);
    const float* lb = (const float*)(ws + OFF_LB);
#pragma unroll
    for (int nb = 0; nb < 4; ++nb) {
      int col = (nt & 7) * 128 + nb * 32 + l31;
      float oml = 1.f;
      if (sec == 1) oml = 1.f - lb[col]; else if (sec == 2) oml = 1.f - lb[1024 + col];
#pragma unroll
      for (int i = 0; i < 16; ++i) {
        float v = acc[nb][i], o;
        if (sec == 1 || sec == 2) o = oml * sigmf(-v);
        else if (sec == 4) o = siluf(v);
        else o = v;
        dst[(size_t)(tok0 + crow(i, hh)) * DM + col] = f2bf(o);
      }
    }
  }
};

DI void store_block32_packed(uint2 (&o)[4], bf16_t* blk, int hh) {
#pragma unroll
  for (int k = 0; k < 4; k += 2) {
    const auto rx = __builtin_amdgcn_permlane32_swap(o[k].x, o[k + 1].x, false, false);
    const auto ry = __builtin_amdgcn_permlane32_swap(o[k].y, o[k + 1].y, false, false);
    *(uint4*)(blk + 8 * k + 8 * hh) = make_uint4(rx[0], ry[0], rx[1], ry[1]);
  }
}
DI void norm128_store(f32x16 (&acc)[4], const float* w, bf16_t* dst, int hh) {
  float ss = 0.f;
#pragma unroll
  for (int nb = 0; nb < 4; ++nb)
#pragma unroll
    for (int i = 0; i < 16; ++i) ss += acc[nb][i] * acc[nb][i];
  ss = half_sum(ss);
  float rs = rsqrtf(ss * (1.f / 128.f) + EPS);
#pragma unroll
  for (int nb = 0; nb < 4; ++nb) {
    uint2 o[4];
#pragma unroll
    for (int g = 0; g < 4; ++g) {
      int f = nb * 32 + 8 * g + 4 * hh;
      float4 wv4 = *(const float4*)(w + f);
      o[g].x = pk2(acc[nb][4 * g] * rs * wv4.x, acc[nb][4 * g + 1] * rs * wv4.y);
      o[g].y = pk2(acc[nb][4 * g + 2] * rs * wv4.z, acc[nb][4 * g + 3] * rs * wv4.w);
    }
    store_block32_packed(o, dst + nb * 32, hh);
  }
}
DI void norm64_rope_store(f32x16& a0, f32x16& a1, const float* w, bf16_t* dst, int hh, bool rope, int prow, int pcol, const float* cosT, const float* sinT) {
  float ss = 0.f;
#pragma unroll
  for (int i = 0; i < 16; ++i) ss += a0[i] * a0[i] + a1[i] * a1[i];
  ss = half_sum(ss);
  float rs = rsqrtf(ss * (1.f / 64.f) + EPS);
#pragma unroll
  for (int i = 0; i < 16; ++i) { int f = crow(i, hh); a0[i] = a0[i] * rs * w[f]; a1[i] = a1[i] * rs * w[32 + f]; }
  if (rope) {
#pragma unroll
    for (int i = 0; i < 8; ++i) {
      int j = crow(i, hh);
      float c0 = cosT[prow * 16 + j], s0 = sinT[prow * 16 + j], c1 = cosT[pcol * 16 + j], s1 = sinT[pcol * 16 + j];
      float t1 = a0[i], t2 = a0[i + 8];
      a0[i] = t1 * c0 - t2 * s0; a0[i + 8] = t2 * c0 + t1 * s0;
      float t3 = a1[i], t4 = a1[i + 8];
      a1[i] = t3 * c1 - t4 * s1; a1[i + 8] = t4 * c1 + t3 * s1;
    }
  }
  uint2 o0[4], o1[4];
#pragma unroll
  for (int g = 0; g < 4; ++g) {
    o0[g].x = pk2(a0[4 * g], a0[4 * g + 1]); o0[g].y = pk2(a0[4 * g + 2], a0[4 * g + 3]);
    o1[g].x = pk2(a1[4 * g], a1[4 * g + 1]); o1[g].y = pk2(a1[4 * g + 2], a1[4 * g + 3]);
  }
  store_block32_packed(o0, dst, hh);
  store_block32_packed(o1, dst + 32, hh);
}
DI void vt_store(f32x16 (&acc)[4], bf16_t* vt  , int pos0, int hh) {
  const int kq = pos0 & 15, pos = (pos0 & ~15) | (8 * ((kq >> 2) & 1) + (kq & 3) + 4 * (kq >> 3));
#pragma unroll
  for (int nb = 0; nb < 4; ++nb)
#pragma unroll
    for (int i = 0; i < 16; ++i) vt[(size_t)(nb * 32 + crow(i, hh)) * PL + pos] = f2bf(acc[nb][i]);
}

struct EpiMlaUq {
  char* ws; const float* qn_w; const float* qr_w;
  DI void operator()(f32x16 (&acc)[4], int tok0, int nt, int lane, bool part = false) const {
    const int l31 = lane & 31, hh = lane >> 5;
    const int b = tok0 / PL, pos = tok0 - b * PL + l31, pt = (pos < CTXL) ? 0 : 1;
    bf16_t* Q = (bf16_t*)(ws + MLA_Q);
    if (nt < 8) {
      norm128_store(acc, qn_w, Q + ((size_t)(b * 8 + nt) * PL + pos) * 192, hh);
    } else {
      const bool rope = pt != 0; const int t = pos - CTXL;
      const float* cosT = (const float*)(ws + OFF_COS); const float* sinT = (const float*)(ws + OFF_SIN);
      int h0 = (nt - 8) * 2;
      norm64_rope_store(acc[0], acc[1], qr_w, Q + ((size_t)(b * 8 + h0) * PL + pos) * 192 + 128, hh, rope, rope ? (t >> 6) : 0, rope ? (t & 63) : 0, cosT, sinT);
      norm64_rope_store(acc[2], acc[3], qr_w, Q + ((size_t)(b * 8 + h0 + 1) * PL + pos) * 192 + 128, hh, rope, rope ? (t >> 6) : 0, rope ? (t & 63) : 0, cosT, sinT);
    }
  }
};
struct EpiMlaUkv {
  char* ws; const float* kn_w;
  DI void operator()(f32x16 (&acc)[4], int tok0, int nt, int lane, bool part = false) const {
    const int l31 = lane & 31, hh = lane >> 5;
    const int b = tok0 / PL, pos = tok0 - b * PL + l31, head = nt >> 1;
    if ((nt & 1) == 0) norm128_store(acc, kn_w, (bf16_t*)(ws + MLA_K) + ((size_t)(b * 8 + head) * PL + pos) * 192, hh);
    else vt_store(acc, (bf16_t*)(ws + MLA_VT) + (size_t)(b * 8 + head) * 128 * PL, pos, hh);
  }
};
struct EpiDfQkv {
  char* ws; const float* qn_w; const float* kn_w;
  DI void operator()(f32x16 (&acc)[4], int tok0, int nt, int lane, bool part = false) const {
    const int l31 = lane & 31, hh = lane >> 5;
    const int b = tok0 / PL, pos = tok0 - b * PL + l31, pt = (pos < CTXL) ? 0 : 1;
    if (nt < 16) {
      const bool isq = nt < 8; const int head = nt & 7;
      bf16_t* dst = (bf16_t*)(ws + (isq ? DF_Q : DF_K));
      const float* w = isq ? qn_w : kn_w;
      const bool rope = pt != 0; const int t = pos - CTXL;
      const float* cosT = (const float*)(ws + OFF_COS); const float* sinT = (const float*)(ws + OFF_SIN);
      norm64_rope_store(acc[0], acc[1], w, dst + ((size_t)((b * 8 + head) * 2 + 0) * PL + pos) * 64, hh, rope, rope ? (t >> 6) : 0, rope ? (t & 63) : 0, cosT, sinT);
      norm64_rope_store(acc[2], acc[3], w, dst + ((size_t)((b * 8 + head) * 2 + 1) * PL + pos) * 64, hh, rope, rope ? (t >> 6) : 0, rope ? (t & 63) : 0, cosT, sinT);
    } else {
      vt_store(acc, (bf16_t*)(ws + DF_VT) + (size_t)(b * 8 + (nt - 16)) * 128 * PL, pos, hh);
    }
  }
};

DI void phase_mla_post(const Params& p, int j) {
  const int lane = TID() & 63, wv = TID() >> 6;
  const float* raw = (const float*)(p.ws + MLA_Q);
  bf16_t* cqn = (bf16_t*)(p.ws + MLA_CQN);
  bf16_t* ckvn = (bf16_t*)(p.ws + MLA_CKVN);
  bf16_t* Kb = (bf16_t*)(p.ws + MLA_K);
  const float* qnw = p.in[12] + j * 384; const float* kvnw = p.in[13] + j * 256; const float* krw = p.in[19] + j * 64;
  const float* cosT = (const float*)(p.ws + OFF_COS); const float* sinT = (const float*)(p.ws + OFF_SIN);
  for (int r = BID() * 8 + wv; r < NT; r += gridDim.x * 8) {
    const float* x = raw + (size_t)r * 704;
    float q[6], kv[4], kr;
    float sq = 0.f, skv = 0.f;
#pragma unroll
    for (int u = 0; u < 6; ++u) { q[u] = x[lane + 64 * u]; sq += q[u] * q[u]; }
#pragma unroll
    for (int u = 0; u < 4; ++u) { kv[u] = x[384 + lane + 64 * u]; skv += kv[u] * kv[u]; }
    kr = x[640 + lane];
    sq = wave_sum(sq); skv = wave_sum(skv);
    float skr = wave_sum(kr * kr);
    float rq = rsqrtf(sq * (1.f / 384.f) + EPS), rkv = rsqrtf(skv * (1.f / 256.f) + EPS), rkr = rsqrtf(skr * (1.f / 64.f) + EPS);
#pragma unroll
    for (int u = 0; u < 6; ++u) cqn[(size_t)r * 384 + lane + 64 * u] = f2bf(q[u] * rq * qnw[lane + 64 * u]);
#pragma unroll
    for (int u = 0; u < 4; ++u) ckvn[(size_t)r * 256 + lane + 64 * u] = f2bf(kv[u] * rkv * kvnw[lane + 64 * u]);
    float v = kr * rkr * krw[lane];
    int b = r / PL, pp = r - b * PL;
    float other = __shfl_xor(v, 16);
    if (pp >= CTXL) {
      int t = pp - CTXL, pos = (lane < 32) ? (t >> 6) : (t & 63), jf = lane & 15;
      float c = cosT[pos * 16 + jf], s = sinT[pos * 16 + jf];
      float rot = (lane & 16) ? other : -other;
      v = v * c + rot * s;
    }
    unsigned short vb = f2bf(v);
#pragma unroll
    for (int h = 0; h < 8; ++h) Kb[((size_t)(b * 8 + h) * PL + pp) * 192 + 128 + lane] = vb;
  }
}

template <int DQK, int NM>
DI void attn_item(const bf16_t* Qb, const bf16_t* Kb, size_t mstride, const bf16_t* VTb,
                  int q0, int nkt, float cs, bf16_t* Orow  , float lam, float outscale, const float* subw, char* smem) {
  constexpr int KSTR = DQK * 2 + 16, KT_BYTES = NM * 64 * KSTR, VSTR = 144, VT_BYTES = 128 * VSTR, BUF = KT_BYTES + VT_BYTES;
  constexpr int KCH = DQK / 8, NKC = NM * 64 * KCH / NTHR, WPM = 8 / NM, NS = DQK / 16;
  const int tid = TID(), lane = tid & 63, wv = tid >> 6, l31 = lane & 31, hh = lane >> 5;
  const int m = wv / WPM, wq = wv % WPM;
  const int qp = q0 + wq * 32 + l31;
  bf16x8 qf[NS];
  {
    const bf16_t* qptr = Qb + m * mstride + (size_t)qp * DQK + hh * 8;
#pragma unroll
    for (int s = 0; s < NS; ++s) qf[s] = *(const bf16x8*)(qptr + s * 16);
  }
  f32x16 oacc[4];
#pragma unroll
  for (int db = 0; db < 4; ++db)
#pragma unroll
    for (int i = 0; i < 16; ++i) oacc[db][i] = 0.f;
  float mrun = -1e30f, lrun = 0.f;
  uint4 kreg0, kreg1, kreg2, vreg0, vreg1;
  kreg2 = make_uint4(0, 0, 0, 0);
  int kgo[3], klo[3];
#pragma unroll
  for (int j = 0; j < 3; ++j) {
    int c = tid + NTHR * j, mm = c / (64 * KCH), rem = c - mm * (64 * KCH), row = rem / KCH, kc = rem - row * KCH;
    kgo[j] = row * DQK + kc * 8; klo[j] = (mm * 64 + row) * KSTR + kc * 16;
    if (NM == 2) kgo[j] += mm * (int)mstride;
  }
  const int vgo0 = (tid >> 3) * PL + (tid & 7) * 8, vgo1 = ((tid + NTHR) >> 3) * PL + (tid & 7) * 8;
  const int vlo0 = KT_BYTES + (tid >> 3) * VSTR + (tid & 7) * 16, vlo1 = KT_BYTES + ((tid + NTHR) >> 3) * VSTR + (tid & 7) * 16;
#define GLOAD(kt_) do { const bf16_t* kp_ = Kb + (size_t)(kt_) * 64 * DQK; const bf16_t* vp_ = VTb + (kt_) * 64; \
    kreg0 = *(const uint4*)(kp_ + kgo[0]); kreg1 = *(const uint4*)(kp_ + kgo[1]); if (NKC > 2) kreg2 = *(const uint4*)(kp_ + kgo[2]); \
    vreg0 = *(const uint4*)(vp_ + vgo0); vreg1 = *(const uint4*)(vp_ + vgo1); } while (0)
#define SSTORE(buf_) do { char* b_ = (buf_); \
    *(uint4*)(b_ + klo[0]) = kreg0; *(uint4*)(b_ + klo[1]) = kreg1; if (NKC > 2) *(uint4*)(b_ + klo[2]) = kreg2; \
    *(uint4*)(b_ + vlo0) = vreg0; *(uint4*)(b_ + vlo1) = vreg1; } while (0)
  GLOAD(0); SSTORE(smem); __syncthreads();
  for (int kt = 0; kt < nkt; ++kt) {
    const char* cur = smem + (kt & 1) * BUF;
    GLOAD(kt + 1 < nkt ? kt + 1 : kt);
    PIN();
    f32x16 sacc[2];
#pragma unroll
    for (int kb = 0; kb < 2; ++kb)
#pragma unroll
      for (int i = 0; i < 16; ++i) sacc[kb][i] = 0.f;
    const char* kbase = cur + (m * 64 + l31) * KSTR + hh * 16;
    {
      bf16x8 kfa[4], kfb[4];
#define KLD(dst_, s_) do { dst_[0] = *(const bf16x8*)(kbase + (s_) * 32); dst_[1] = *(const bf16x8*)(kbase + 32 * KSTR + (s_) * 32); \
        dst_[2] = *(const bf16x8*)(kbase + ((s_) + 1) * 32); dst_[3] = *(const bf16x8*)(kbase + 32 * KSTR + ((s_) + 1) * 32); } while (0)
#define KMM(src_, s_) do { sacc[0] = MFMA(src_[0], qf[s_], sacc[0]); sacc[1] = MFMA(src_[1], qf[s_], sacc[1]); \
        sacc[0] = MFMA(src_[2], qf[(s_) + 1], sacc[0]); sacc[1] = MFMA(src_[3], qf[(s_) + 1], sacc[1]); } while (0)
      KLD(kfa, 0);
#pragma unroll
      for (int g = 0; g < NS / 2; ++g) {
        PIN();
        if (g + 1 < NS / 2) { if (g & 1) KLD(kfa, 2 * g + 2); else KLD(kfb, 2 * g + 2); }
        PIN();
        if (g & 1) KMM(kfb, 2 * g); else KMM(kfa, 2 * g);
      }
#undef KLD
#undef KMM
    }
    float mx = sacc[0][0];
#pragma unroll
    for (int i = 1; i < 16; ++i) mx = fmaxf(mx, sacc[0][i]);
#pragma unroll
    for (int i = 0; i < 16; ++i) mx = fmaxf(mx, sacc[1][i]);
    {
      const auto rr = __builtin_amdgcn_permlane32_swap(__float_as_uint(mx), __float_as_uint(mx), false, false);
      mx = fmaxf(__uint_as_float(rr[0]), __uint_as_float(rr[1]));
    }
    if (__any((mx - mrun) * cs > 8.f)) {
      const float mnew = fmaxf(mrun, mx);
      const float alpha = __builtin_amdgcn_exp2f((mrun - mnew) * cs);
      mrun = mnew;
      lrun *= alpha;
#pragma unroll
      for (int db = 0; db < 4; ++db)
#pragma unroll
        for (int i = 0; i < 16; ++i) oacc[db][i] *= alpha;
    }
    {
      const f32x2_t cs2 = {cs, cs}, mc2 = {mrun * cs, mrun * cs};
      f32x2_t ps2 = {0.f, 0.f};
#pragma unroll
      for (int kb = 0; kb < 2; ++kb)
#pragma unroll
        for (int i = 0; i < 16; i += 2) {
          f32x2_t t = {sacc[kb][i], sacc[kb][i + 1]};
          t = t * cs2 - mc2;
          t.x = __builtin_amdgcn_exp2f(t.x); t.y = __builtin_amdgcn_exp2f(t.y);
          sacc[kb][i] = t.x; sacc[kb][i + 1] = t.y;
          ps2 = ps2 + t;
        }
      lrun += ps2.x + ps2.y;
    }
    const char* vbase = cur + KT_BYTES + l31 * VSTR + hh * 16;
    {
      struct VF { bf16x8 v; };
      VF vfa[4], vfb[4];
#define VLD(dst_, s4_) do { _Pragma("unroll") for (int db = 0; db < 4; ++db) dst_[db].v = *(const bf16x8*)(vbase + db * 32 * VSTR + (s4_) * 32); } while (0)
      VLD(vfa, 0);
#pragma unroll
      for (int s4 = 0; s4 < 4; ++s4) {
        const int kb = s4 >> 1, sp = s4 & 1;
        PIN();
        if (s4 < 3) { if (s4 & 1) VLD(vfa, s4 + 1); else VLD(vfb, s4 + 1); }
        union { bf16x8 v; unsigned u[4]; } pf;
#pragma unroll
        for (int e = 0; e < 4; ++e) pf.u[e] = pk2(sacc[kb][8 * sp + 2 * e], sacc[kb][8 * sp + 2 * e + 1]);
        PIN();
#pragma unroll
        for (int db = 0; db < 4; ++db) { if (s4 & 1) oacc[db] = MFMA(vfb[db].v, pf.v, oacc[db]); else oacc[db] = MFMA(vfa[db].v, pf.v, oacc[db]); }
        {
          char* b_ = smem + ((kt + 1) & 1) * BUF;
          if (s4 == 0) { *(uint4*)(b_ + klo[0]) = kreg0; if (NKC > 2) *(uint4*)(b_ + klo[2]) = kreg2; }
          if (s4 == 1) { *(uint4*)(b_ + klo[1]) = kreg1; }
          if (s4 == 2) { *(uint4*)(b_ + vlo0) = vreg0; }
          if (s4 == 3) { *(uint4*)(b_ + vlo1) = vreg1; }
        }
      }
#undef VLD
    }
    PIN();
    __syncthreads();
  }
#undef GLOAD
#undef SSTORE
  lrun = half_sum(lrun);
  const float inv = 1.f / lrun;
#pragma unroll
  for (int db = 0; db < 4; ++db)
#pragma unroll
    for (int i = 0; i < 16; ++i) oacc[db][i] *= inv;
  if (NM == 2) {
    float* cb = (float*)smem;
    if (m == 1) {
#pragma unroll
      for (int db = 0; db < 4; ++db)
#pragma unroll
        for (int i = 0; i < 16; ++i) cb[(wq * 64 + db * 16 + i) * 64 + lane] = oacc[db][i];
    }
    __syncthreads();
    if (m == 0) {
      float ss = 0.f;
#pragma unroll
      for (int db = 0; db < 4; ++db)
#pragma unroll
        for (int i = 0; i < 16; ++i) { float o = oacc[db][i] - lam * cb[(wq * 64 + db * 16 + i) * 64 + lane]; oacc[db][i] = o; ss += o * o; }
      ss = half_sum(ss);
      const float rs = rsqrtf(ss * (1.f / 128.f) + EPS) * outscale;
#pragma unroll
      for (int db = 0; db < 4; ++db)
#pragma unroll
        for (int g = 0; g < 4; ++g) {
          int d = db * 32 + 8 * g + 4 * hh;
          float4 w4 = *(const float4*)(subw + d);
          uint2 o;
          o.x = pk2(oacc[db][4 * g] * rs * w4.x, oacc[db][4 * g + 1] * rs * w4.y);
          o.y = pk2(oacc[db][4 * g + 2] * rs * w4.z, oacc[db][4 * g + 3] * rs * w4.w);
          *(uint2*)(Orow + (size_t)qp * DM + d) = o;
        }
    }
    __syncthreads();
  } else {
#pragma unroll
    for (int db = 0; db < 4; ++db) {
      uint2 o[4];
#pragma unroll
      for (int g = 0; g < 4; ++g) { o[g].x = pk2(oacc[db][4 * g], oacc[db][4 * g + 1]); o[g].y = pk2(oacc[db][4 * g + 2], oacc[db][4 * g + 3]); }
      store_block32_packed(o, Orow + (size_t)qp * DM + db * 32, hh);
    }
  }
}

DI void attn_item_df2(const bf16_t* Qb, const bf16_t* Kb, size_t mstride, const bf16_t* VTb, int q0, int nkt  , float cs,
                      bf16_t* Orow, float lam, float outscale, const float* subw, char* smem) {
  constexpr int DQK = 64, KSTR = 144, KT_BYTES = 2 * 64 * KSTR, VSTR = 144, VT_BYTES = 128 * VSTR;
  const int tid = TID(), lane = tid & 63, wv = tid >> 6, l31 = lane & 31, hh = lane >> 5;
  const int m = wv >> 2, wq = wv & 3;
  const int qp = q0 + wq * 32 + l31;
  bf16x8 qf[4];
  {
    const bf16_t* qptr = Qb + m * mstride + (size_t)qp * DQK + hh * 8;
#pragma unroll
    for (int s = 0; s < 4; ++s) qf[s] = *(const bf16x8*)(qptr + s * 16);
  }
  f32x16 oacc[4];
#pragma unroll
  for (int db = 0; db < 4; ++db)
#pragma unroll
    for (int i = 0; i < 16; ++i) oacc[db][i] = 0.f;
  float mrun = -1e30f, lrun = 0.f;
  uint4 kreg0, kreg1, vreg0, vreg1;
  const int c1 = tid + NTHR;
  const int kgo0 = (tid >> 9) * (int)mstride + ((tid & 511) >> 3) * DQK + (tid & 7) * 8, kgo1 = (c1 >> 9) * (int)mstride + ((c1 & 511) >> 3) * DQK + (c1 & 7) * 8;
  const int klo0 = ((tid >> 9) * 64 + ((tid & 511) >> 3)) * KSTR + (tid & 7) * 16, klo1 = ((c1 >> 9) * 64 + ((c1 & 511) >> 3)) * KSTR + (c1 & 7) * 16;
  const int vgo0 = (tid >> 3) * PL + (tid & 7) * 8, vgo1 = (c1 >> 3) * PL + (tid & 7) * 8;
  const int vlo0 = (tid >> 3) * VSTR + (tid & 7) * 16, vlo1 = (c1 >> 3) * VSTR + (tid & 7) * 16;
  const int kfo = (m * 64 + l31) * KSTR + hh * 16;
  const int vfo = 2 * KT_BYTES + l31 * VSTR + hh * 16;
  union PF { bf16x8 v; unsigned u[4]; };
  PF pf[4];
  f32x16 pA[2], pB[2];
#define D2_GLOAD(t_) do { const bf16_t* kp_ = Kb + (size_t)(t_) * 64 * DQK; const bf16_t* vp_ = VTb + (t_) * 64; \
    kreg0 = *(const uint4*)(kp_ + kgo0); kreg1 = *(const uint4*)(kp_ + kgo1); vreg0 = *(const uint4*)(vp_ + vgo0); vreg1 = *(const uint4*)(vp_ + vgo1); } while (0)
#define D2_SSTORE(ks_, vs_) do { char* kb_ = smem + (ks_) * KT_BYTES; char* vb_ = smem + 2 * KT_BYTES + (vs_) * VT_BYTES; \
    *(uint4*)(kb_ + klo0) = kreg0; *(uint4*)(kb_ + klo1) = kreg1; *(uint4*)(vb_ + vlo0) = vreg0; *(uint4*)(vb_ + vlo1) = vreg1; } while (0)
#define D2_RESCALE(mx_) do { if (__any(((mx_) - mrun) * cs > 8.f)) { const float mnew = fmaxf(mrun, (mx_)); const float alpha = __builtin_amdgcn_exp2f((mrun - mnew) * cs); \
      mrun = mnew; lrun *= alpha; \
      _Pragma("unroll") for (int db = 0; db < 4; ++db) _Pragma("unroll") for (int i = 0; i < 16; ++i) oacc[db][i] *= alpha; } } while (0)
#define D2_HALFMAX(mx_) do { const auto rr_ = __builtin_amdgcn_permlane32_swap(__float_as_uint(mx_), __float_as_uint(mx_), false, false); \
      mx_ = fmaxf(__uint_as_float(rr_[0]), __uint_as_float(rr_[1])); } while (0)
#define D2_FIN(prev_, step_) do { const int kbp_ = (step_) >> 2, ii_ = ((step_) & 3) * 4; \
      f32x2_t t0_ = {prev_[kbp_][ii_], prev_[kbp_][ii_ + 1]}, t1_ = {prev_[kbp_][ii_ + 2], prev_[kbp_][ii_ + 3]}; \
      t0_ = t0_ * cs2 - mc2; t1_ = t1_ * cs2 - mc2; \
      t0_.x = __builtin_amdgcn_exp2f(t0_.x); t0_.y = __builtin_amdgcn_exp2f(t0_.y); t1_.x = __builtin_amdgcn_exp2f(t1_.x); t1_.y = __builtin_amdgcn_exp2f(t1_.y); \
      ps2 = ps2 + t0_; ps2 = ps2 + t1_; \
      pf[2 * kbp_ + (ii_ >> 3)].u[(ii_ & 7) >> 1] = pk2(t0_.x, t0_.y); pf[2 * kbp_ + (ii_ >> 3)].u[((ii_ & 7) >> 1) + 1] = pk2(t1_.x, t1_.y); } while (0)
#define D2_SEG_A(cur_, prev_, ks_, FIN_) do { \
      const char* kb_ = smem + (ks_) * KT_BYTES + kfo; bf16x8 kf_[8]; \
      _Pragma("unroll") for (int st_ = 0; st_ < 8; ++st_) kf_[st_] = *(const bf16x8*)(kb_ + (st_ & 1) * 32 * KSTR + (st_ >> 1) * 32); \
      _Pragma("unroll") for (int kb2_ = 0; kb2_ < 2; ++kb2_) _Pragma("unroll") for (int i = 0; i < 16; ++i) cur_[kb2_][i] = 0.f; \
      _Pragma("unroll") for (int st_ = 0; st_ < 8; ++st_) { \
        PIN(); \
        cur_[st_ & 1] = MFMA(kf_[st_], qf[st_ >> 1], cur_[st_ & 1]); \
        if (FIN_ && (st_ & 1) == 0) { D2_FIN(prev_, (st_ >> 1)); } \
      } \
      PIN(); } while (0)
#define D2_SEG_B(cur_, prev_, vs_, MAX_, FIN2_, ST_, kns_, vns_, mx_) do { \
      const char* vb_ = smem + vfo + (vs_) * VT_BYTES; bf16x8 vfa_[4], vfb_[4]; \
      _Pragma("unroll") for (int db = 0; db < 4; ++db) vfa_[db] = *(const bf16x8*)(vb_ + db * 32 * VSTR); \
      _Pragma("unroll") for (int s4 = 0; s4 < 4; ++s4) { \
        PIN(); \
        if (s4 < 3) { _Pragma("unroll") for (int db = 0; db < 4; ++db) { if (s4 & 1) vfa_[db] = *(const bf16x8*)(vb_ + db * 32 * VSTR + (s4 + 1) * 32); else vfb_[db] = *(const bf16x8*)(vb_ + db * 32 * VSTR + (s4 + 1) * 32); } } \
        PIN(); \
        _Pragma("unroll") for (int db = 0; db < 4; ++db) { \
          if (s4 & 1) oacc[db] = MFMA(vfb_[db], pf[s4].v, oacc[db]); else oacc[db] = MFMA(vfa_[db], pf[s4].v, oacc[db]); \
          if (FIN2_ && s4 < 2 && (db & 1) == 0) { PIN(); D2_FIN(prev_, 4 + 2 * s4 + (db >> 1)); PIN(); } \
          if (MAX_ && s4 >= 2 && (db & 1) == 0) { PIN(); _Pragma("unroll") for (int i = 0; i < 8; ++i) mx_ = fmaxf(mx_, cur_[s4 - 2][(db >> 1) * 8 + i]); PIN(); } \
        } \
        if (ST_) { char* kw_ = smem + (kns_) * KT_BYTES; char* vw_ = smem + 2 * KT_BYTES + (vns_) * VT_BYTES; \
          if (s4 == 0) *(uint4*)(kw_ + klo0) = kreg0; if (s4 == 1) *(uint4*)(kw_ + klo1) = kreg1; \
          if (s4 == 2) *(uint4*)(vw_ + vlo0) = vreg0; if (s4 == 3) *(uint4*)(vw_ + vlo1) = vreg1; } \
      } \
      PIN(); } while (0)
#define D2_ITER(j_, cur_, prev_) do { \
      D2_GLOAD((j_) + 1 < nkt ? (j_) + 1 : (j_)); PIN(); \
      const f32x2_t cs2 = {cs, cs}, mc2 = {mrun * cs, mrun * cs}; f32x2_t ps2 = {0.f, 0.f}; \
      D2_SEG_A(cur_, prev_, (j_) & 1, true); \
      float mx_ = -1e30f; const int v1_ = vs0 == 2 ? 0 : vs0 + 1, v2_ = v1_ == 2 ? 0 : v1_ + 1; \
      D2_SEG_B(cur_, prev_, vs0, true, true, true, ((j_) + 1) & 1, v2_, mx_); \
      lrun += ps2.x + ps2.y; \
      D2_HALFMAX(mx_); D2_RESCALE(mx_); \
      vs0 = v1_; \
      __syncthreads(); } while (0)
  int vs0 = 0;
  D2_GLOAD(0); D2_SSTORE(0, 0); __syncthreads();
  D2_GLOAD(1); PIN();
  { const f32x2_t cs2 = {cs, cs}, mc2 = {0.f, 0.f}; f32x2_t ps2 = {0.f, 0.f}; D2_SEG_A(pA, pB, 0, false); (void)cs2; (void)mc2; (void)ps2; }
  { float mx0 = pA[0][0];
#pragma unroll
    for (int i = 1; i < 16; ++i) mx0 = fmaxf(mx0, pA[0][i]);
#pragma unroll
    for (int i = 0; i < 16; ++i) mx0 = fmaxf(mx0, pA[1][i]);
    D2_HALFMAX(mx0); D2_RESCALE(mx0); }
  PIN();
  D2_SSTORE(1, 1);
  __syncthreads();
  for (int j = 1; j < nkt - 1; j += 2) {
    D2_ITER(j, pB, pA);
    D2_ITER(j + 1, pA, pB);
  }
  D2_ITER(nkt - 1, pB, pA);
  {
    const f32x2_t cs2 = {cs, cs}, mc2 = {mrun * cs, mrun * cs}; f32x2_t ps2 = {0.f, 0.f};
#pragma unroll
    for (int st = 0; st < 8; ++st) { D2_FIN(pB, st); }
    lrun += ps2.x + ps2.y;
    float mxd = 0.f;
    D2_SEG_B(pB, pB, vs0, false, false, false, 0, 0, mxd);
  }
  __syncthreads();
#undef D2_GLOAD
#undef D2_SSTORE
#undef D2_RESCALE
#undef D2_HALFMAX
#undef D2_FIN
#undef D2_SEG_A
#undef D2_SEG_B
#undef D2_ITER
  lrun = half_sum(lrun);
  const float inv = 1.f / lrun;
#pragma unroll
  for (int db = 0; db < 4; ++db)
#pragma unroll
    for (int i = 0; i < 16; ++i) oacc[db][i] *= inv;
  float* cb = (float*)smem;
  if (m == 1) {
#pragma unroll
    for (int db = 0; db < 4; ++db)
#pragma unroll
      for (int i = 0; i < 16; ++i) cb[(wq * 64 + db * 16 + i) * 64 + lane] = oacc[db][i];
  }
  __syncthreads();
  if (m == 0) {
    float ss = 0.f;
#pragma unroll
    for (int db = 0; db < 4; ++db)
#pragma unroll
      for (int i = 0; i < 16; ++i) { float o = oacc[db][i] - lam * cb[(wq * 64 + db * 16 + i) * 64 + lane]; oacc[db][i] = o; ss += o * o; }
    ss = half_sum(ss);
    const float rs = rsqrtf(ss * (1.f / 128.f) + EPS) * outscale;
#pragma unroll
    for (int db = 0; db < 4; ++db) {
      uint2 o[4];
#pragma unroll
      for (int g = 0; g < 4; ++g) {
        int d = db * 32 + 8 * g + 4 * hh;
        float4 w4 = *(const float4*)(subw + d);
        o[g].x = pk2(oacc[db][4 * g] * rs * w4.x, oacc[db][4 * g + 1] * rs * w4.y);
        o[g].y = pk2(oacc[db][4 * g + 2] * rs * w4.z, oacc[db][4 * g + 3] * rs * w4.w);
      }
      store_block32_packed(o, Orow + (size_t)qp * DM + db * 32, hh);
    }
  }
  __syncthreads();
}

DI void phase_attn_mla(const Params& p, bool do_ctx, char* smem) {
  const bf16_t* Q = (const bf16_t*)(p.ws + MLA_Q); const bf16_t* K = (const bf16_t*)(p.ws + MLA_K); const bf16_t* VT = (const bf16_t*)(p.ws + MLA_VT);
  bf16_t* O = (bf16_t*)(p.ws + OFF_ABUF);
  const float cs = 1.4426950408889634f / sqrtf(192.f);
  const int xcd = BID() & 7, slot = BID() >> 3, nslots = gridDim.x >> 3;
  for (int q = slot; q < 4 * 32; q += nslots) {
    int bh = (q >> 5) * 8 + xcd, qb = (q & 31) + 1;
    int b = bh >> 3, h = bh & 7;
    attn_item<192, 1>(Q + (size_t)bh * PL * 192, K + (size_t)bh * PL * 192, 0, VT + (size_t)bh * 128 * PL, qb * 256, PL / 64, cs,
                      O + (size_t)b * PL * DM + h * 128, 0.f, 1.f, nullptr, smem);
  }
  if (do_ctx) {
    for (int bh = BID(); bh < 32; bh += gridDim.x) {
      int b = bh >> 3, h = bh & 7;
      attn_item<192, 1>(Q + (size_t)bh * PL * 192, K + (size_t)bh * PL * 192, 0, VT + (size_t)bh * 128 * PL, 0, CTXL / 64, cs,
                        O + (size_t)b * PL * DM + h * 128, 0.f, 1.f, nullptr, smem);
    }
  }
}

DI void phase_attn_df(const Params& p, bool do_ctx, char* smem) {
  const bf16_t* Q = (const bf16_t*)(p.ws + DF_Q); const bf16_t* K = (const bf16_t*)(p.ws + DF_K); const bf16_t* VT = (const bf16_t*)(p.ws + DF_VT);
  bf16_t* O = (bf16_t*)(p.ws + OFF_ABUF);
  const float cs = 1.4426950408889634f / sqrtf(64.f);
  const float lam = *(const float*)(p.ws + OFF_LAM);
  const float lam_init = 0.8f - 0.6f * expf(-0.3f * 2.f);
  const float* subw = p.in[29];
  const int xcd = BID() & 7, slot = BID() >> 3, nslots = gridDim.x >> 3;
  for (int q = slot; q < 4 * 64; q += nslots) {
    int bh = (q >> 6) * 8 + xcd, qb = (q & 63) + 2;
    int b = bh >> 3, h = bh & 7;
    attn_item_df2(Q + (size_t)bh * 2 * PL * 64, K + (size_t)bh * 2 * PL * 64, (size_t)PL * 64, VT + (size_t)bh * 128 * PL, qb * 128, PL / 64, cs,
                     O + (size_t)b * PL * DM + h * 128, lam, 1.f - lam_init, subw, smem);
  }
  if (do_ctx) {
    for (int it = BID(); it < 64; it += gridDim.x) {
      int bh = it >> 1, qb = it & 1;
      int b = bh >> 3, h = bh & 7;
      attn_item_df2(Q + (size_t)bh * 2 * PL * 64, K + (size_t)bh * 2 * PL * 64, (size_t)PL * 64, VT + (size_t)bh * 128 * PL, qb * 128, CTXL / 64, cs,
                       O + (size_t)b * PL * DM + h * 128, lam, 1.f - lam_init, subw, smem);
    }
  }
}

constexpr int SC_T = 32;
constexpr int SC_BUF = SC_T * 128 * 4 * 2 + SC_T * 32 * 4;
DI float dpp_row_sum16(float v) {
  v += __int_as_float(__builtin_amdgcn_update_dpp(0, __float_as_int(v), 0xB1, 0xF, 0xF, true));
  v += __int_as_float(__builtin_amdgcn_update_dpp(0, __float_as_int(v), 0x4E, 0xF, 0xF, true));
  v += __int_as_float(__builtin_amdgcn_update_dpp(0, __float_as_int(v), 0x141, 0xF, 0xF, true));
  v += __int_as_float(__builtin_amdgcn_update_dpp(0, __float_as_int(v), 0x140, 0xF, 0xF, true));
  return v;
}
DI void phase_hg_scan(const Params& p, char* smem) {
  const int tid = TID(), lane = tid & 63, wv = tid >> 6;
  const int dpart = lane & 15, esub = lane >> 4, el = wv * 4 + esub;
  const bf16_t* qb = (const bf16_t*)(p.ws + HG_Q);
  const bf16_t* ib = (const bf16_t*)(p.ws + HG_I);
  const int ltok = tid >> 4, ldc = tid & 15;
  const int vtok = (tid & 127) >> 2, vec = tid & 3;
  for (int item = BID(); item < 256; item += gridDim.x) {
    const int b = item >> 6, h = (item >> 3) & 7, dir = (item >> 2) & 1, eq = item & 3;
    const bf16_t* kk = (const bf16_t*)(p.ws + (dir ? HG_KB : HG_KF));
    bf16_t* oo = (bf16_t*)(p.ws + (dir ? HG_OB : OFF_ABUF));
    const size_t rowbase = (size_t)b * PL;
    const int colq = h * 128 + ldc * 8, colv = h * 128 + eq * 32 + vec * 8, colo = h * 128 + eq * 32 + el;
    auto posf = [&](int tau) { return dir ? (tau < CTXL ? CTXL - 1 - tau : PL - 1 - (tau - CTXL)) : tau; };
    f32x2_t S[4];
#pragma unroll
    for (int j = 0; j < 4; ++j) S[j] = f32x2_t{0.f, 0.f};
    uint4 aq, ak, av, bq, bk, bv;
    av = make_uint4(0, 0, 0, 0); bv = av;
#define SC_LOAD(rq_, rk_, rv_, c_) do { const size_t r_ = rowbase + posf((c_) * SC_T + ltok); \
      rq_ = *(const uint4*)(qb + r_ * DM + colq); rk_ = *(const uint4*)(kk + r_ * DM + colq); \
      if (tid < 128) { const size_t r2_ = rowbase + posf((c_) * SC_T + vtok); rv_ = *(const uint4*)(ib + r2_ * DM + colv); } } while (0)
#define SC_UNPK(dst_, u_) do { float4 lo_, hi_; lo_.x = __uint_as_float((u_).x << 16); lo_.y = __uint_as_float((u_).x & 0xffff0000u); lo_.z = __uint_as_float((u_).y << 16); lo_.w = __uint_as_float((u_).y & 0xffff0000u); \
      hi_.x = __uint_as_float((u_).z << 16); hi_.y = __uint_as_float((u_).z & 0xffff0000u); hi_.z = __uint_as_float((u_).w << 16); hi_.w = __uint_as_float((u_).w & 0xffff0000u); \
      *(float4*)(dst_) = lo_; *(float4*)((dst_) + 4) = hi_; } while (0)
#define SC_STORE(rq_, rk_, rv_, buf_) do { float* fb_ = (float*)(buf_); SC_UNPK(fb_ + ltok * 128 + ldc * 8, rq_); SC_UNPK(fb_ + SC_T * 128 + ltok * 128 + ldc * 8, rk_); \
      if (tid < 128) SC_UNPK(fb_ + 2 * SC_T * 128 + vtok * 32 + vec * 8, rv_); } while (0)
#define SC_COMPUTE(buf_, c_) do { const float* fb_ = (const float*)(buf_); \
      for (int t0_ = 0; t0_ < SC_T; t0_ += 16) { \
        float keep_ = 0.f; \
        _Pragma("unroll") for (int u_ = 0; u_ < 16; ++u_) { const int t_ = t0_ + u_; \
          const float4 q0_ = *(const float4*)(fb_ + t_ * 128 + dpart * 8), q1_ = *(const float4*)(fb_ + t_ * 128 + dpart * 8 + 4); \
          const float4 k0_ = *(const float4*)(fb_ + SC_T * 128 + t_ * 128 + dpart * 8), k1_ = *(const float4*)(fb_ + SC_T * 128 + t_ * 128 + dpart * 8 + 4); \
          const float v_ = fb_[2 * SC_T * 128 + t_ * 32 + el]; const f32x2_t v2_ = {v_, v_}; \
          const f32x2_t kk0_ = {k0_.x, k0_.y}, kk1_ = {k0_.z, k0_.w}, kk2_ = {k1_.x, k1_.y}, kk3_ = {k1_.z, k1_.w}; \
          const f32x2_t qq0_ = {q0_.x, q0_.y}, qq1_ = {q0_.z, q0_.w}, qq2_ = {q1_.x, q1_.y}, qq3_ = {q1_.z, q1_.w}; \
          S[0] = S[0] + kk0_ * (v2_ - S[0]); S[1] = S[1] + kk1_ * (v2_ - S[1]); S[2] = S[2] + kk2_ * (v2_ - S[2]); S[3] = S[3] + kk3_ * (v2_ - S[3]); \
          f32x2_t pp_ = S[0] * qq0_; pp_ = pp_ + S[1] * qq1_; pp_ = pp_ + S[2] * qq2_; pp_ = pp_ + S[3] * qq3_; \
          const float part_ = dpp_row_sum16(pp_.x + pp_.y); \
          keep_ = (dpart == u_) ? part_ : keep_; \
        } \
        oo[(rowbase + posf((c_) * SC_T + t0_ + dpart)) * DM + colo] = f2bf(keep_); \
      } } while (0)
    constexpr int NCH = PL / SC_T;
    SC_LOAD(aq, ak, av, 0); SC_STORE(aq, ak, av, smem);
    SC_LOAD(aq, ak, av, 1);
    __syncthreads();
    for (int c = 0; c < NCH; c += 2) {
      SC_LOAD(bq, bk, bv, (c + 2 < NCH ? c + 2 : c));
      PIN();
      SC_COMPUTE(smem, c);
      PIN();
      SC_STORE(aq, ak, av, smem + SC_BUF);
      __syncthreads();
      SC_LOAD(aq, ak, av, (c + 3 < NCH ? c + 3 : c));
      PIN();
      SC_COMPUTE(smem + SC_BUF, c + 1);
      PIN();
      SC_STORE(bq, bk, bv, smem);
      __syncthreads();
    }
#undef SC_LOAD
#undef SC_UNPK
#undef SC_STORE
#undef SC_COMPUTE
  }
}

DI void phase_hg_readout(const Params& p, int j) {
  const int lane = TID() & 63, wv = TID() >> 6;
  bf16_t* of = (bf16_t*)(p.ws + OFF_ABUF);
  const bf16_t* ob = (const bf16_t*)(p.ws + HG_OB);
  const bf16_t* sg = (const bf16_t*)(p.ws + HG_G);
  const float* onw = p.in[23] + j * 128;
  for (int r = BID() * 8 + wv; r < NT; r += gridDim.x * 8) {
    const size_t base = (size_t)r * DM + lane * 16;
    uint4 a[2], bq[2], g[2];
    a[0] = *(const uint4*)(of + base); a[1] = *(const uint4*)(of + base + 8);
    bq[0] = *(const uint4*)(ob + base); bq[1] = *(const uint4*)(ob + base + 8);
    g[0] = *(const uint4*)(sg + base); g[1] = *(const uint4*)(sg + base + 8);
    float o[16], gg[16];
#pragma unroll
    for (int u = 0; u < 2; ++u) {
      const unsigned aw[4] = {a[u].x, a[u].y, a[u].z, a[u].w}, bw[4] = {bq[u].x, bq[u].y, bq[u].z, bq[u].w}, gw[4] = {g[u].x, g[u].y, g[u].z, g[u].w};
#pragma unroll
      for (int c = 0; c < 4; ++c) {
        o[u * 8 + 2 * c] = __uint_as_float(aw[c] << 16) + __uint_as_float(bw[c] << 16);
        o[u * 8 + 2 * c + 1] = __uint_as_float(aw[c] & 0xffff0000u) + __uint_as_float(bw[c] & 0xffff0000u);
        gg[u * 8 + 2 * c] = __uint_as_float(gw[c] << 16);
        gg[u * 8 + 2 * c + 1] = __uint_as_float(gw[c] & 0xffff0000u);
      }
    }
    float ss = 0.f;
#pragma unroll
    for (int c = 0; c < 16; ++c) ss += o[c] * o[c];
    ss += __shfl_xor(ss, 1); ss += __shfl_xor(ss, 2); ss += __shfl_xor(ss, 4);
    const float rs = rsqrtf(ss * (1.f / 128.f) + EPS);
    const int d0 = (lane & 7) * 16;
    unsigned ow[8];
#pragma unroll
    for (int c = 0; c < 8; ++c) ow[c] = pk2(o[2 * c] * rs * onw[d0 + 2 * c] * gg[2 * c], o[2 * c + 1] * rs * onw[d0 + 2 * c + 1] * gg[2 * c + 1]);
    *(uint4*)(of + base) = make_uint4(ow[0], ow[1], ow[2], ow[3]);
    *(uint4*)(of + base + 8) = make_uint4(ow[4], ow[5], ow[6], ow[7]);
  }
}


#define XB_TMO      128
#define XB_XCNT(j)  (256  + 64 * (j))
#define XB_XSUB(j)  (1280 + 64 * (j))
#define XB_XGEN(j)  (2304 + 64 * (j))
#define XB_TOP      3328
#define XB_TOPGEN   3392
#define XCD_BAR_WORDS 3456
#define XB_SPIN_CAP (1u << 20)
#define LAS __attribute__((address_space(3)))
DI unsigned xb_ld(unsigned* p)              { return __hip_atomic_load(p, __ATOMIC_RELAXED, __HIP_MEMORY_SCOPE_AGENT); }
DI unsigned xb_add(unsigned* p, unsigned v) { return __hip_atomic_fetch_add(p, v, __ATOMIC_RELAXED, __HIP_MEMORY_SCOPE_AGENT); }
DI unsigned xb_xcc_id() { return (unsigned)__builtin_amdgcn_s_getreg((3 << 11) | 20) & 0xFu; }
#define XB_SPIN(cond, bar) do { unsigned _sp = 0; while (cond) { __builtin_amdgcn_s_sleep(1); \
    if ((++_sp & 255u) == 0u) { if (xb_ld(&(bar)[XB_TMO])) break; if (_sp > XB_SPIN_CAP) { atomicAdd(&(bar)[XB_TMO], 1u); break; } } } } while (0)
struct XcdBarrier { unsigned* bar; unsigned x; volatile LAS unsigned* st; };
DI XcdBarrier xcd_barrier_post(unsigned* bar, volatile LAS unsigned* st) {
  XcdBarrier b; b.bar = bar; b.x = xb_xcc_id(); b.st = st;
  if (threadIdx.x == 0) (void)xb_add(&bar[XB_XCNT(b.x)], 1u);
  return b;
}
DI void xcd_barrier_complete(unsigned* bar, unsigned x, unsigned& nloc, unsigned& nx) {
  const unsigned G = gridDim.x * gridDim.y * gridDim.z;
  unsigned sum, cnt, mine, sp = 0u;
  for (;;) {
    sum = 0u; cnt = 0u; mine = 0u;
#pragma unroll
    for (unsigned j = 0; j < 16; ++j) { const unsigned c = xb_ld(&bar[XB_XCNT(j)]); sum += c; cnt += (c > 0u) ? 1u : 0u; mine = (j == x) ? c : mine; }
    if (sum == G) break;
    __builtin_amdgcn_s_sleep(1);
    if ((++sp & 255u) == 0u) { if (xb_ld(&bar[XB_TMO])) break; if (sp > XB_SPIN_CAP) { atomicAdd(&bar[XB_TMO], 1u); break; } }
  }
  nloc = mine > 0u ? mine : 1u; nx = cnt > 0u ? cnt : 1u;
}
DI void xcd_barrier(const XcdBarrier& b) {
  asm volatile("s_waitcnt vmcnt(0)" ::: "memory");
  __syncthreads();
  if (threadIdx.x == 0) {
    unsigned* bar = b.bar;
    __builtin_amdgcn_s_waitcnt(0);
    unsigned nloc = b.st[0], nx = b.st[1];
    if (nloc == 0u) { xcd_barrier_complete(bar, b.x, nloc, nx); b.st[0] = nloc; b.st[1] = nx; }
    const unsigned old = xb_add(&bar[XB_XSUB(b.x)], 1u);
    const unsigned gen = old / nloc;
    if (old + 1u == (gen + 1u) * nloc) {
      __builtin_amdgcn_fence(__ATOMIC_RELEASE, "agent");
      asm volatile("s_waitcnt vmcnt(0)" ::: "memory");
      const unsigned og = xb_add(&bar[XB_TOP], 1u);
      const unsigned tg = og / nx;
      if (og + 1u == (tg + 1u) * nx) xb_add(&bar[XB_TOPGEN], 1u);
      else XB_SPIN(xb_ld(&bar[XB_TOPGEN]) == tg, bar);
      __builtin_amdgcn_fence(__ATOMIC_ACQUIRE, "agent");
      xb_add(&bar[XB_XGEN(b.x)], 1u);
      asm volatile("s_waitcnt vmcnt(0)" ::: "memory");
    } else {
      XB_SPIN(xb_ld(&bar[XB_XGEN(b.x)]) == gen, bar);
      __builtin_amdgcn_fence(__ATOMIC_ACQUIRE, "agent");
      asm volatile("s_waitcnt vmcnt(0)" ::: "memory");
    }
  }
  __syncthreads();
}

constexpr int PH_PER_LAYER = 9;
constexpr int N_PHASES = 1 + 4 * PH_PER_LAYER;

DI void run_phase(const Params& p, int ph, char* smem, int rep = 0) {
  if (ph == 0) { phase0(p, smem); return; }
  const int layer = (ph - 1) / PH_PER_LAYER, sub = (ph - 1) % PH_PER_LAYER;
  const int kind = layer % 3, j = layer / 3;
  const bool last = layer == 3;
  const float* modsL = (const float*)(p.ws + OFF_MODS) + (size_t)layer * 5 * 6144;
  const bf16_t* abuf = (const bf16_t*)(p.ws + OFF_ABUF);
  char* mix = p.ws + OFF_MIX;
  switch (sub) {
    case 0:
      phase_norm(p, p.in[6] + layer * DM, modsL, 0, 1, false);
      phase_convert(p, layer);
      break;
    case 1:
      if (kind == 0) { EpiMlaIn e{(float*)(p.ws + MLA_Q)}; gemm_phase<2, false>(abuf, (const bf16_t*)mix, 1024, 3, false, e, smem); }
      else if (kind == 1) { EpiHgIn e{p.ws}; gemm_phase_pref<2, false>(abuf, (const bf16_t*)mix, 1024, 20, false, e, smem); }
      else { EpiDfQkv e{p.ws, p.in[26], p.in[27]}; gemm_phase<2, true>(abuf, (const bf16_t*)mix, 1024, 12, false, e, smem); }
      break;
    case 2:
      if (kind == 0) phase_mla_post(p, j);
      else if (kind == 1) phase_hg_scan(p, smem);
      else phase_attn_df(p, !last, smem);
      break;
    case 3:
      if (kind == 0) {
        EpiMlaUq e1{p.ws, p.in[16] + j * 128, p.in[17] + j * 64};
        gemm_phase<2, true>((const bf16_t*)(p.ws + MLA_CQN), (const bf16_t*)(mix + 1572864), 384, 6, false, e1, smem);
        EpiMlaUkv e2{p.ws, p.in[18] + j * 128};
        gemm_phase<2, true>((const bf16_t*)(p.ws + MLA_CKVN), (const bf16_t*)(mix + 2752512), 256, 8, false, e2, smem);
      } else if (kind == 1) phase_hg_readout(p, j);
      break;
    case 4:
      if (kind == 0) phase_attn_mla(p, !last, smem);
      break;
    case 5: {
      EpiX e{&p, modsL + 2 * 1024, rep ? 0.f : 1.f};
      const bf16_t* wo = (const bf16_t*)(mix + (kind == 0 ? 3801088 : kind == 1 ? 10485760 : 6291456));
      gemm_phase<2, false, 8>(abuf, wo, 1024, 4, last, e, smem);
    } break;
    case 6:
      phase_norm(p, p.in[7] + layer * DM, modsL, 3, 4, last);
      break;
    case 7: {
      EpiFfnUp e{(bf16_t*)(p.ws + FFN_H)};
      gemm_phase_pref<2, false>(abuf, (const bf16_t*)(p.ws + OFF_W13), 1024, 22, last, e, smem);
    } break;
    case 8: {
      EpiX e{&p, modsL + 5 * 1024, rep ? 0.f : 1.f};
      gemm_phase<2, false, 8>((const bf16_t*)(p.ws + FFN_H), (const bf16_t*)(p.ws + OFF_W2), DFF, 4, last, e, smem);
    } break;
  }
}

DI bool phase_empty(int ph) {
  if (ph == 0) return false;
  const int layer = (ph - 1) / PH_PER_LAYER, sub = (ph - 1) % PH_PER_LAYER, kind = layer % 3;
  return (sub == 4 && kind != 0) || (sub == 3 && kind == 2);
}

__global__ void __launch_bounds__(NTHR) mega_kernel(Params p) {
  extern __shared__ __attribute__((aligned(16))) char smem[];
  cg::grid_group grid = cg::this_grid();
#if !MULTI_LAUNCH
  volatile LAS unsigned* st = (volatile LAS unsigned*)(smem + LDS_PHASE);
  if (threadIdx.x == 0) { st[0] = 0u; st[1] = 0u; st[2] = 0u; st[3] = 0u; }
  __syncthreads();
  const XcdBarrier xb = xcd_barrier_post((unsigned*)(p.ws + OFF_BAR), st);
#endif
  for (int ph = p.ph_lo; ph < p.ph_hi; ++ph) {
    if (phase_empty(ph)) continue;
#if PROBE_ON
    const int nrep = (PROBE_SEL(ph)) ? 2 : 1;
    for (int rep = 0; rep < nrep; ++rep) { run_phase(p, ph, smem, rep); if (rep + 1 < nrep) grid.sync(); }
#else
    run_phase(p, ph, smem);
#endif
    if (ph + 1 < p.ph_hi) {
#if MULTI_LAUNCH
      grid.sync();
#else
      if (ph == 0) grid.sync();
      else xcd_barrier(xb);
#endif
    }
  }
}

extern "C" void kernel_launch(void* const* d_in, const int* in_sizes, int n_in, void* d_out, int out_size, void* d_ws, size_t ws_size, hipStream_t stream) {
  static int grid_blocks = 0;
  if (grid_blocks == 0) {
    if (n_in != 31 || ws_size < WS_NEED) { fprintf(stderr, "kernel_launch: unexpected n_in %d / ws_size %zu (need %zu)\n", n_in, ws_size, (size_t)WS_NEED); grid_blocks = -1; return; }
    int dev = 0, cus = 0, per_cu = 0;
    hipGetDevice(&dev);
    hipDeviceGetAttribute(&cus, hipDeviceAttributeMultiprocessorCount, dev);
    if (hipFuncSetAttribute((const void*)mega_kernel, hipFuncAttributeMaxDynamicSharedMemorySize, LDS_BYTES) != hipSuccess) { fprintf(stderr, "hipFuncSetAttribute failed\n"); grid_blocks = -1; return; }
    if (hipOccupancyMaxActiveBlocksPerMultiprocessor(&per_cu, (const void*)mega_kernel, NTHR, LDS_BYTES) != hipSuccess || per_cu < 1) { fprintf(stderr, "occupancy query: %d\n", per_cu); per_cu = 1; }
    (void)hipGetLastError();
    grid_blocks = cus * 1;
    if (grid_blocks % 8 != 0 || grid_blocks < 8) grid_blocks = 256;
  }
  if (grid_blocks < 0) return;
  Params p{};
  for (int i = 0; i < 31; ++i) p.in[i] = (const float*)d_in[i];
  p.out = (float*)d_out; p.ws = (char*)d_ws;
#if MULTI_LAUNCH
  for (int ph = 0; ph < N_PHASES; ++ph) {
    p.ph_lo = ph; p.ph_hi = ph + 1;
    void* args[] = {&p};
    hipError_t e = hipLaunchCooperativeKernel((const void*)mega_kernel, dim3(grid_blocks), dim3(NTHR), args, LDS_BYTES, stream);
    if (e != hipSuccess) { fprintf(stderr, "launch failed: %s\n", hipGetErrorString(e)); break; }
  }
#else
  p.ph_lo = 0; p.ph_hi = N_PHASES;
  if (hipMemsetAsync((char*)d_ws + OFF_BAR, 0, XCD_BAR_WORDS * 4, stream) != hipSuccess) { fprintf(stderr, "memset of barrier words failed\n"); return; }
  void* args[] = {&p};
  hipError_t e = hipLaunchCooperativeKernel((const void*)mega_kernel, dim3(grid_blocks), dim3(NTHR), args, LDS_BYTES, stream);
  if (e != hipSuccess) fprintf(stderr, "cooperative launch failed: %s (grid %d)\n", hipGetErrorString(e), grid_blocks);
#endif
}
```

```cpp
#include <hip/hip_runtime.h>
#include <hip/hip_cooperative_groups.h>
#include <cstdio>
namespace cg = cooperative_groups;

#define DI __device__ __forceinline__
#define PIN() do { asm volatile("" ::: "memory"); __builtin_amdgcn_sched_barrier(0); } while (0)
#ifndef MULTI_LAUNCH
#define MULTI_LAUNCH 0
#endif
#define PROBE_ON 0
#define PROBE_SEL(ph) (((ph) - 1) % 9 == 1 || (ph) == 4 || (ph) == 31 || ((ph) - 1) % 9 == 5 || ((ph) - 1) % 9 == 7 || ((ph) - 1) % 9 == 8)

typedef unsigned short bf16_t;
using bf16x8 = __attribute__((ext_vector_type(8))) short;
using f32x16 = __attribute__((ext_vector_type(16))) float;
#define MFMA(a, b, c) __builtin_amdgcn_mfma_f32_32x32x16_bf16((a), (b), (c), 0, 0, 0)

constexpr int NB = 4, SEQ = 8192, CTXL = 256, PL = 8448, NT = NB * PL, DM = 1024, DFF = 2816;
constexpr int MT = NT / 256;
constexpr int PT = PL / 256;
constexpr int NTHR = 512;
constexpr float EPS = 1e-6f;

constexpr size_t OFF_W13 = 0;
constexpr size_t OFF_W2 = 11534336;
constexpr size_t OFF_MIX = 17301504;
constexpr size_t OFF_MODS = 33554432;
constexpr size_t OFF_LB = OFF_MODS + 524288;
constexpr size_t OFF_LAM = OFF_MODS + 540672;
constexpr size_t OFF_COS = OFF_MODS + 544768;
constexpr size_t OFF_SIN = OFF_MODS + 552960;
constexpr size_t OFF_BAR = OFF_MODS + 589824;
constexpr size_t OFF_CTXX = 34603008;
constexpr size_t OFF_ABUF = 38797312;
constexpr size_t OFF_SCR = 108003328;
constexpr size_t ACT16 = (size_t)NT * DM * 2;
constexpr size_t WS_NEED = OFF_SCR + 6 * ACT16;
constexpr size_t MLA_Q = OFF_SCR;
constexpr size_t MLA_K = MLA_Q + (size_t)NT * 8 * 192 * 2;
constexpr size_t MLA_VT = MLA_K + (size_t)NT * 8 * 192 * 2;
constexpr size_t MLA_CQN = MLA_VT + ACT16;
constexpr size_t MLA_CKVN = MLA_CQN + (size_t)NT * 384 * 2;
constexpr size_t HG_Q = OFF_SCR, HG_KF = HG_Q + ACT16, HG_KB = HG_KF + ACT16, HG_I = HG_KB + ACT16, HG_G = HG_I + ACT16, HG_OB = HG_G + ACT16;
constexpr size_t DF_Q = OFF_SCR, DF_K = DF_Q + ACT16, DF_VT = DF_K + ACT16;
constexpr size_t FFN_H = OFF_SCR;

constexpr int LDS_PHASE = 147456;
constexpr int LDS_BYTES = LDS_PHASE + 16;

struct Params {
  const float* in[31];
  float* out;
  char* ws;
  int ph_lo, ph_hi;
};

DI int TID() { int t = threadIdx.x; asm volatile("" : "+v"(t)); return t; }
DI int BID() { int t = blockIdx.x; asm volatile("" : "+s"(t)); return t; }
DI float bf2f(unsigned short v) { return __uint_as_float(((unsigned)v) << 16); }
typedef float f32x2_t __attribute__((ext_vector_type(2)));
typedef __bf16 bf16x2_t __attribute__((ext_vector_type(2)));
DI unsigned pk2(float a, float b) { f32x2_t v = {a, b}; bf16x2_t r = __builtin_convertvector(v, bf16x2_t); return __builtin_bit_cast(unsigned, r); }
DI unsigned short f2bf(float x) { return (unsigned short)(pk2(x, 0.f) & 0xffffu); }
DI float sigmf(float x) { return __builtin_amdgcn_rcpf(1.f + __builtin_amdgcn_exp2f(-1.4426950408889634f * x)); }
DI float siluf(float x) { return x * sigmf(x); }
DI int crow(int i, int h) { return (i & 3) + 8 * (i >> 2) + 4 * h; }
DI float wave_sum(float v) {
#pragma unroll
  for (int o = 32; o > 0; o >>= 1) v += __shfl_xor(v, o);
  return v;
}
DI float* xrow(const Params& p, int r) {
  int b = r / PL, pp = r - b * PL;
  return pp < CTXL ? (float*)(p.ws + OFF_CTXX) + (size_t)(b * CTXL + pp) * DM : p.out + (size_t)(b * SEQ + pp - CTXL) * DM;
}

DI void phase0(const Params& p, char* smem) {
  const int tid = TID(), lane = tid & 63, wv = tid >> 6;
  const size_t gsz = (size_t)gridDim.x * NTHR, gid = (size_t)BID() * NTHR + tid;
  {
    const float4* xs = (const float4*)p.in[0]; float4* xd = (float4*)p.out;
    for (size_t i = gid; i < (size_t)NB * SEQ * DM / 4; i += gsz) xd[i] = xs[i];
    const float4* cs = (const float4*)p.in[2]; float4* cd = (float4*)(p.ws + OFF_CTXX);
    for (size_t i = gid; i < (size_t)NB * CTXL * DM / 4; i += gsz) cd[i] = cs[i];
  }
  if (gid < 2048) {
    int pos = (int)gid >> 4, j = (int)gid & 15;
    float invf = powf(10000.f, -(float)(2 * j) / 32.f);
    float ang = (float)pos * invf;
    ((float*)(p.ws + OFF_COS))[gid] = cosf(ang);
    ((float*)(p.ws + OFF_SIN))[gid] = sinf(ang);
  }
  if (gid >= 2048 && gid < 4096) {
    int d = (int)gid - 2048;
    const float* lg = p.in[22];
    float l0 = lg[d], l1 = lg[2048 + d], l2 = lg[4096 + d], l3 = lg[6144 + d];
    float mx = fmaxf(fmaxf(l0, l1), fmaxf(l2, l3));
    float e0 = expf(l0 - mx), e1 = expf(l1 - mx), e2 = expf(l2 - mx), e3 = expf(l3 - mx);
    ((float*)(p.ws + OFF_LB))[d] = e1 / (e0 + e1 + e2 + e3);
  }
  if (gid == 4096) {
    const float* lv = p.in[28];
    float s01 = 0.f, s23 = 0.f;
    for (int j = 0; j < 64; ++j) { s01 += lv[j] * lv[64 + j]; s23 += lv[128 + j] * lv[192 + j]; }
    float lam_init = 0.8f - 0.6f * expf(-0.3f * 2.f);
    ((float*)(p.ws + OFF_LAM))[0] = expf(s01) - expf(s23) + lam_init;
  }
  float* sS = (float*)smem;
  float* red = sS + 5 * 1024;
  for (int i = tid; i < 5 * 1024; i += NTHR) {
    int r = i >> 10, k = i & 1023;
    float c = r < 4 ? p.in[1][r * 1024 + k] : p.in[3][k];
    sS[i] = siluf(c);
  }
  __syncthreads();
  float* mods = (float*)(p.ws + OFF_MODS);
  for (int job = BID(); job < 4 * 96; job += gridDim.x) {
    int li = job / 96, cgp = job % 96, n = cgp * 64 + lane;
    const float* W = p.in[4] + ((size_t)li * 1024 + wv * 128) * 6144 + n;
    float a0 = 0, a1 = 0, a2 = 0, a3 = 0, a4 = 0;
#pragma unroll 4
    for (int k = 0; k < 128; ++k) {
      float w = W[(size_t)k * 6144];
      int kk = wv * 128 + k;
      a0 += sS[kk] * w; a1 += sS[1024 + kk] * w; a2 += sS[2048 + kk] * w; a3 += sS[3072 + kk] * w; a4 += sS[4096 + kk] * w;
    }
    red[(wv * 5 + 0) * 64 + lane] = a0; red[(wv * 5 + 1) * 64 + lane] = a1; red[(wv * 5 + 2) * 64 + lane] = a2;
    red[(wv * 5 + 3) * 64 + lane] = a3; red[(wv * 5 + 4) * 64 + lane] = a4;
    __syncthreads();
    if (tid < 320) {
      int r = tid >> 6, l = tid & 63;
      float s = 0.f;
#pragma unroll
      for (int w = 0; w < 8; ++w) s += red[(w * 5 + r) * 64 + l];
      int nn = cgp * 64 + l;
      mods[(size_t)(li * 5 + r) * 6144 + nn] = s + p.in[5][li * 6144 + nn];
    }
    __syncthreads();
  }
}

DI void convert_w(const float* src, const float* src2, int srcN, int K, bf16_t* dst, int Nd, int mode) {
  const size_t gsz = (size_t)gridDim.x * NTHR, gid = (size_t)BID() * NTHR + TID();
  const size_t total = (size_t)Nd * (K >> 3);
  for (size_t e = gid; e < total; e += gsz) {
    int nd = (int)(e % Nd), k0 = (int)(e / Nd) * 8;
    const float* s = src; int col = nd; bool valid = true;
    if (mode == 0) { valid = nd < srcN; }
    else if (mode == 1) { int g = nd >> 6, w = nd & 63; if (w < 32) col = g * 32 + w; else { s = src2; col = g * 32 + w - 32; } }
    else { if (nd < 1024) col = (nd >> 7) * 192 + (nd & 127); else { int r = nd - 1024; col = (r >> 6) * 192 + 128 + (r & 63); } }
    float v[8];
#pragma unroll
    for (int j = 0; j < 8; ++j) v[j] = valid ? s[(size_t)(k0 + j) * srcN + col] : 0.f;
    uint4 o; o.x = pk2(v[0], v[1]); o.y = pk2(v[2], v[3]); o.z = pk2(v[4], v[5]); o.w = pk2(v[6], v[7]);
    *(uint4*)(dst + (size_t)nd * K + k0) = o;
  }
}

DI void phase_convert(const Params& p, int layer) {
  const int kind = layer % 3, j = layer / 3;
  convert_w(p.in[8] + (size_t)layer * DM * DFF, p.in[9] + (size_t)layer * DM * DFF, DFF, DM, (bf16_t*)(p.ws + OFF_W13), 2 * DFF, 1);
  convert_w(p.in[10] + (size_t)layer * DFF * DM, nullptr, DM, DFF, (bf16_t*)(p.ws + OFF_W2), DM, 0);
  char* mix = p.ws + OFF_MIX;
  if (kind == 0) {
    convert_w(p.in[11] + (size_t)j * 1024 * 704, nullptr, 704, 1024, (bf16_t*)(mix), 768, 0);
    convert_w(p.in[14] + (size_t)j * 384 * 1536, nullptr, 1536, 384, (bf16_t*)(mix + 1572864), 1536, 2);
    convert_w(p.in[15] + (size_t)j * 256 * 2048, nullptr, 2048, 256, (bf16_t*)(mix + 2752512), 2048, 0);
    convert_w(p.in[20] + (size_t)j * 1024 * 1024, nullptr, 1024, 1024, (bf16_t*)(mix + 3801088), 1024, 0);
  } else if (kind == 1) {
    convert_w(p.in[21] + (size_t)j * 1024 * 5120, nullptr, 5120, 1024, (bf16_t*)(mix), 5120, 0);
    convert_w(p.in[24] + (size_t)j * 1024 * 1024, nullptr, 1024, 1024, (bf16_t*)(mix + 10485760), 1024, 0);
  } else {
    convert_w(p.in[25] + (size_t)j * 1024 * 3072, nullptr, 3072, 1024, (bf16_t*)(mix), 3072, 0);
    convert_w(p.in[30] + (size_t)j * 1024 * 1024, nullptr, 1024, 1024, (bf16_t*)(mix + 6291456), 1024, 0);
  }
}

DI void phase_norm(const Params& p, const float* nw, const float* modsL, int selShift, int selScale, bool skipctx) {
  const int lane = TID() & 63, wv = TID() >> 6;
  bf16_t* abuf = (bf16_t*)(p.ws + OFF_ABUF);
  const int stride = gridDim.x * 8;
  int r = BID() * 8 + wv;
  float4 w[4];
#pragma unroll
  for (int q = 0; q < 4; ++q) w[q] = *(const float4*)(nw + (lane + 64 * q) * 4);
  float4 v[4], vn[4];
  if (r < NT) {
    const float4* x = (const float4*)xrow(p, r);
#pragma unroll
    for (int q = 0; q < 4; ++q) v[q] = x[lane + 64 * q];
  }
  for (; r < NT; r += stride) {
    const int rn = r + stride;
    if (rn < NT) {
      const float4* xn = (const float4*)xrow(p, rn);
#pragma unroll
      for (int q = 0; q < 4; ++q) vn[q] = xn[lane + 64 * q];
    }
    const int b = r / PL, pp = r - b * PL;
    const bool isctx = pp < CTXL;
    if (!(skipctx && isctx)) {
      const float* md = modsL + (size_t)(isctx ? 4 : b) * 6144;
      float ss = 0.f;
#pragma unroll
      for (int q = 0; q < 4; ++q) ss += v[q].x * v[q].x + v[q].y * v[q].y + v[q].z * v[q].z + v[q].w * v[q].w;
      ss = wave_sum(ss);
      const float rs = rsqrtf(ss * (1.f / 1024.f) + EPS);
#pragma unroll
      for (int q = 0; q < 4; ++q) {
        const int k0 = (lane + 64 * q) * 4;
        const float4 sc = *(const float4*)(md + selScale * 1024 + k0), sh = *(const float4*)(md + selShift * 1024 + k0);
        const float a0 = v[q].x * rs * w[q].x * (1.f + sc.x) + sh.x, a1 = v[q].y * rs * w[q].y * (1.f + sc.y) + sh.y;
        const float a2 = v[q].z * rs * w[q].z * (1.f + sc.z) + sh.z, a3 = v[q].w * rs * w[q].w * (1.f + sc.w) + sh.w;
        uint2 o; o.x = pk2(a0, a1); o.y = pk2(a2, a3);
        *(uint2*)(abuf + (size_t)r * DM + k0) = o;
      }
    }
#pragma unroll
    for (int q = 0; q < 4; ++q) v[q] = vn[q];
  }
}

constexpr int GSTR = 144;

template <int WM, bool SWAP, int NSPLIT = 0, class Epi>
DI void gemm_phase(const bf16_t* A, const bf16_t* W, int K, int ntiles, bool skipctx, const Epi& epi, char* smem) {
  constexpr int BN = 128 * WM, GBUF = (256 + BN) * GSTR;
  const int tid = TID(), lane = tid & 63, wv = tid >> 6, l31 = lane & 31, hh = lane >> 5;
  const int wm = (WM == 1) ? wv : (wv & 3), wn = (WM == 1) ? 0 : (wv >> 2);
  const int xcd = BID() & 7, slot = BID() >> 3, nslots = gridDim.x >> 3;
  const int nk = K >> 6;
  const int tiles_x = ((MT - xcd + 7) >> 3) * ntiles;
  constexpr int NSP = NSPLIT > 0 ? NSPLIT : 1;
  const int full = NSPLIT > 0 ? (tiles_x / nslots) * nslots : tiles_x;
  const int nunits = full + (tiles_x - full) * NSP;
  for (int u = slot; u < nunits; u += nslots) {
    const bool part = u >= full;
    const int q = part ? full + (u - full) / NSP : u, ks = part ? (u - full) % NSP : 0;
    const int mtl = q / ntiles, nt = q - mtl * ntiles, mt = mtl * 8 + xcd;
    if (skipctx && (mt % PT) == 0) continue;
    const int kt0 = part ? (ks * nk) / NSP : 0, kt1 = part ? ((ks + 1) * nk) / NSP : nk;
    const bf16_t* Ag = A + (size_t)mt * 256 * K;
    const bf16_t* Wg = W + (size_t)nt * BN * K;
    f32x16 acc[WM][4];
#pragma unroll
    for (int mi = 0; mi < WM; ++mi)
#pragma unroll
      for (int nb = 0; nb < 4; ++nb)
#pragma unroll
        for (int i = 0; i < 16; ++i) acc[mi][nb][i] = 0.f;
    uint4 ra0, ra1, ra2, ra3, rw0, rw1, rw2, rw3;
    rw2 = make_uint4(0, 0, 0, 0); rw3 = rw2;
    const int grow = tid >> 3, gcol = (tid & 7) * 8;
    const bf16_t* ap = Ag + (size_t)grow * K + gcol;
    const bf16_t* wp = Wg + (size_t)grow * K + gcol;
    const int lo = grow * GSTR + (tid & 7) * 16;
#define GLOADG(kt_) do { const int ko_ = (kt_) * 64; \
      ra0 = *(const uint4*)(ap + ko_); ra1 = *(const uint4*)(ap + (size_t)64 * K + ko_); ra2 = *(const uint4*)(ap + (size_t)128 * K + ko_); ra3 = *(const uint4*)(ap + (size_t)192 * K + ko_); \
      rw0 = *(const uint4*)(wp + ko_); rw1 = *(const uint4*)(wp + (size_t)64 * K + ko_); \
      if (WM == 2) { rw2 = *(const uint4*)(wp + (size_t)128 * K + ko_); rw3 = *(const uint4*)(wp + (size_t)192 * K + ko_); } } while (0)
#define SSTOREG(buf_) do { char* b_ = (buf_) + lo; \
      *(uint4*)(b_) = ra0; *(uint4*)(b_ + 64 * GSTR) = ra1; *(uint4*)(b_ + 128 * GSTR) = ra2; *(uint4*)(b_ + 192 * GSTR) = ra3; \
      *(uint4*)(b_ + 256 * GSTR) = rw0; *(uint4*)(b_ + 320 * GSTR) = rw1; \
      if (WM == 2) { *(uint4*)(b_ + 384 * GSTR) = rw2; *(uint4*)(b_ + 448 * GSTR) = rw3; } } while (0)
    GLOADG(kt0); SSTOREG(smem);
    if (WM == 2) GLOADG(kt0 + 1 < kt1 ? kt0 + 1 : kt0);
    __syncthreads();
    for (int kt = kt0; kt < kt1; ++kt) {
      const char* cur = smem + ((kt - kt0) & 1) * GBUF;
      if (WM == 1) { GLOADG(kt + 1 < kt1 ? kt + 1 : kt); PIN(); }
      const char* ab = cur + (wm * 32 * WM + l31) * GSTR + hh * 16;
      const char* wb = cur + (256 + wn * 128 + l31) * GSTR + hh * 16;
      bf16x8 tfA, tfA1, tfB, tfB1, wfA0, wfA1, wfA2, wfA3, wfB0, wfB1, wfB2, wfB3;
#define LDFR(tf_, tf1_, w0_, w1_, w2_, w3_, s_) do { tf_ = *(const bf16x8*)(ab + (s_) * 32); if (WM == 2) tf1_ = *(const bf16x8*)(ab + 32 * GSTR + (s_) * 32); \
        w0_ = *(const bf16x8*)(wb + (s_) * 32); w1_ = *(const bf16x8*)(wb + 32 * GSTR + (s_) * 32); \
        w2_ = *(const bf16x8*)(wb + 64 * GSTR + (s_) * 32); w3_ = *(const bf16x8*)(wb + 96 * GSTR + (s_) * 32); } while (0)
#define DOMM1(mi_, tf_, w0_, w1_, w2_, w3_) do { if (SWAP) { acc[mi_][0] = MFMA(w0_, tf_, acc[mi_][0]); acc[mi_][1] = MFMA(w1_, tf_, acc[mi_][1]); acc[mi_][2] = MFMA(w2_, tf_, acc[mi_][2]); acc[mi_][3] = MFMA(w3_, tf_, acc[mi_][3]); } \
        else { acc[mi_][0] = MFMA(tf_, w0_, acc[mi_][0]); acc[mi_][1] = MFMA(tf_, w1_, acc[mi_][1]); acc[mi_][2] = MFMA(tf_, w2_, acc[mi_][2]); acc[mi_][3] = MFMA(tf_, w3_, acc[mi_][3]); } } while (0)
#define DOMM(tf_, tf1_, w0_, w1_, w2_, w3_) do { DOMM1(0, tf_, w0_, w1_, w2_, w3_); if (WM == 2) DOMM1(WM - 1, tf1_, w0_, w1_, w2_, w3_); } while (0)
      if (WM == 1) {
        LDFR(tfA, tfA1, wfA0, wfA1, wfA2, wfA3, 0);
        LDFR(tfB, tfB1, wfB0, wfB1, wfB2, wfB3, 1);
        PIN();
        DOMM(tfA, tfA1, wfA0, wfA1, wfA2, wfA3);
        PIN();
        LDFR(tfA, tfA1, wfA0, wfA1, wfA2, wfA3, 2);
        PIN();
        DOMM(tfB, tfB1, wfB0, wfB1, wfB2, wfB3);
        PIN();
        LDFR(tfB, tfB1, wfB0, wfB1, wfB2, wfB3, 3);
        PIN();
        DOMM(tfA, tfA1, wfA0, wfA1, wfA2, wfA3);
        DOMM(tfB, tfB1, wfB0, wfB1, wfB2, wfB3);
      } else {
        char* nb_ = smem + ((kt + 1 - kt0) & 1) * GBUF + lo;
#define MM2(mi_, tf_, wa_, wb_, na_, nb2_) do { if (SWAP) { acc[mi_][na_] = MFMA(wa_, tf_, acc[mi_][na_]); acc[mi_][nb2_] = MFMA(wb_, tf_, acc[mi_][nb2_]); } \
          else { acc[mi_][na_] = MFMA(tf_, wa_, acc[mi_][na_]); acc[mi_][nb2_] = MFMA(tf_, wb_, acc[mi_][nb2_]); } } while (0)
        LDFR(tfA, tfA1, wfA0, wfA1, wfA2, wfA3, 0);
        PIN();
        DOMM(tfA, tfA1, wfA0, wfA1, wfA2, wfA3);
        PIN();
        LDFR(tfA, tfA1, wfA0, wfA1, wfA2, wfA3, 1);
        PIN();
        DOMM(tfA, tfA1, wfA0, wfA1, wfA2, wfA3);
        PIN();
        LDFR(tfA, tfA1, wfA0, wfA1, wfA2, wfA3, 2);
        PIN();
        MM2(0, tfA, wfA0, wfA1, 0, 1); PIN(); *(uint4*)(nb_) = ra0; PIN();
        MM2(0, tfA, wfA2, wfA3, 2, 3); PIN(); *(uint4*)(nb_ + 64 * GSTR) = ra1; PIN();
        MM2(1, tfA1, wfA0, wfA1, 0, 1); PIN(); *(uint4*)(nb_ + 128 * GSTR) = ra2; PIN();
        MM2(1, tfA1, wfA2, wfA3, 2, 3); PIN(); *(uint4*)(nb_ + 192 * GSTR) = ra3; PIN();
        LDFR(tfA, tfA1, wfA0, wfA1, wfA2, wfA3, 3);
        PIN();
        MM2(0, tfA, wfA0, wfA1, 0, 1); PIN(); *(uint4*)(nb_ + 256 * GSTR) = rw0; PIN();
        MM2(0, tfA, wfA2, wfA3, 2, 3); PIN(); *(uint4*)(nb_ + 320 * GSTR) = rw1; PIN();
        MM2(1, tfA1, wfA0, wfA1, 0, 1); PIN(); *(uint4*)(nb_ + 384 * GSTR) = rw2; PIN();
        MM2(1, tfA1, wfA2, wfA3, 2, 3); PIN(); *(uint4*)(nb_ + 448 * GSTR) = rw3; PIN();
        GLOADG(kt + 2 < kt1 ? kt + 2 : kt);
#undef MM2
      }
#undef LDFR
#undef DOMM
#undef DOMM1
      PIN();
      if (WM == 1) { if (kt + 1 < kt1) SSTOREG(smem + ((kt + 1 - kt0) & 1) * GBUF); }
      __syncthreads();
    }
#pragma unroll
    for (int mi = 0; mi < WM; ++mi) epi(acc[mi], __builtin_amdgcn_readfirstlane(mt * 256 + (wm * WM + mi) * 32), __builtin_amdgcn_readfirstlane(nt * WM + wn), lane, part);
  }
#undef GLOADG
#undef SSTOREG
}

template <int WM, bool SWAP, int NSPLIT = 0, class Epi>
DI void gemm_phase_pref(const bf16_t* A, const bf16_t* W, int K, int ntiles, bool skipctx, const Epi& epi, char* smem) {
  constexpr int BN = 128 * WM, GBUF = (256 + BN) * GSTR;
  const int tid = TID(), lane = tid & 63, wv = tid >> 6, l31 = lane & 31, hh = lane >> 5;
  const int wm = (WM == 1) ? wv : (wv & 3), wn = (WM == 1) ? 0 : (wv >> 2);
  const int xcd = BID() & 7, slot = BID() >> 3, nslots = gridDim.x >> 3;
  const int nk = K >> 6;
  const int tiles_x = ((MT - xcd + 7) >> 3) * ntiles;
  constexpr int NSP = NSPLIT > 0 ? NSPLIT : 1;
  const int full = NSPLIT > 0 ? (tiles_x / nslots) * nslots : tiles_x;
  const int nunits = full + (tiles_x - full) * NSP;
  uint4 ra0, ra1, ra2, ra3, rw0, rw1, rw2, rw3;
  rw2 = make_uint4(0, 0, 0, 0); rw3 = rw2;
  const int grow = tid >> 3, gcol = (tid & 7) * 8;
  const int lo = grow * GSTR + (tid & 7) * 16;
  const bf16_t* ap = A; const bf16_t* wp = W;
#define GLOADG(kt_) do { const int ko_ = (kt_) * 64; \
      ra0 = *(const uint4*)(ap + ko_); ra1 = *(const uint4*)(ap + (size_t)64 * K + ko_); ra2 = *(const uint4*)(ap + (size_t)128 * K + ko_); ra3 = *(const uint4*)(ap + (size_t)192 * K + ko_); \
      rw0 = *(const uint4*)(wp + ko_); rw1 = *(const uint4*)(wp + (size_t)64 * K + ko_); \
      if (WM == 2) { rw2 = *(const uint4*)(wp + (size_t)128 * K + ko_); rw3 = *(const uint4*)(wp + (size_t)192 * K + ko_); } } while (0)
#define SSTOREG(buf_) do { char* b_ = (buf_) + lo; \
      *(uint4*)(b_) = ra0; *(uint4*)(b_ + 64 * GSTR) = ra1; *(uint4*)(b_ + 128 * GSTR) = ra2; *(uint4*)(b_ + 192 * GSTR) = ra3; \
      *(uint4*)(b_ + 256 * GSTR) = rw0; *(uint4*)(b_ + 320 * GSTR) = rw1; \
      if (WM == 2) { *(uint4*)(b_ + 384 * GSTR) = rw2; *(uint4*)(b_ + 448 * GSTR) = rw3; } } while (0)
#define UNIT_DECODE(u_, mt_, nt_, kt0_, kt1_, part_) do { part_ = (u_) >= full; \
      const int q_ = part_ ? full + ((u_) - full) / NSP : (u_), ks_ = part_ ? ((u_) - full) % NSP : 0; \
      const int mtl_ = q_ / ntiles; nt_ = q_ - mtl_ * ntiles; mt_ = mtl_ * 8 + xcd; \
      kt0_ = part_ ? (ks_ * nk) / NSP : 0; kt1_ = part_ ? ((ks_ + 1) * nk) / NSP : nk; } while (0)
  int u = slot, mt = 0, nt = 0, kt0 = 0, kt1 = 0; bool part = false;
  for (; u < nunits; u += nslots) { UNIT_DECODE(u, mt, nt, kt0, kt1, part); if (!(skipctx && (mt % PT) == 0)) break; }
  if (u < nunits) { ap = A + (size_t)mt * 256 * K + (size_t)grow * K + gcol; wp = W + (size_t)nt * BN * K + (size_t)grow * K + gcol; GLOADG(kt0); }
  while (u < nunits) {
    f32x16 acc[WM][4];
#pragma unroll
    for (int mi = 0; mi < WM; ++mi)
#pragma unroll
      for (int nb = 0; nb < 4; ++nb)
#pragma unroll
        for (int i = 0; i < 16; ++i) acc[mi][nb][i] = 0.f;
    SSTOREG(smem);
    if (WM == 2) GLOADG(kt0 + 1 < kt1 ? kt0 + 1 : kt0);
    __syncthreads();
    for (int kt = kt0; kt < kt1; ++kt) {
      const char* cur = smem + ((kt - kt0) & 1) * GBUF;
      if (WM == 1) { GLOADG(kt + 1 < kt1 ? kt + 1 : kt); PIN(); }
      const char* ab = cur + (wm * 32 * WM + l31) * GSTR + hh * 16;
      const char* wb = cur + (256 + wn * 128 + l31) * GSTR + hh * 16;
      bf16x8 tfA, tfA1, tfB, tfB1, wfA0, wfA1, wfA2, wfA3, wfB0, wfB1, wfB2, wfB3;
#define LDFR(tf_, tf1_, w0_, w1_, w2_, w3_, s_) do { tf_ = *(const bf16x8*)(ab + (s_) * 32); if (WM == 2) tf1_ = *(const bf16x8*)(ab + 32 * GSTR + (s_) * 32); \
        w0_ = *(const bf16x8*)(wb + (s_) * 32); w1_ = *(const bf16x8*)(wb + 32 * GSTR + (s_) * 32); \
        w2_ = *(const bf16x8*)(wb + 64 * GSTR + (s_) * 32); w3_ = *(const bf16x8*)(wb + 96 * GSTR + (s_) * 32); } while (0)
#define DOMM1(mi_, tf_, w0_, w1_, w2_, w3_) do { if (SWAP) { acc[mi_][0] = MFMA(w0_, tf_, acc[mi_][0]); acc[mi_][1] = MFMA(w1_, tf_, acc[mi_][1]); acc[mi_][2] = MFMA(w2_, tf_, acc[mi_][2]); acc[mi_][3] = MFMA(w3_, tf_, acc[mi_][3]); } \
        else { acc[mi_][0] = MFMA(tf_, w0_, acc[mi_][0]); acc[mi_][1] = MFMA(tf_, w1_, acc[mi_][1]); acc[mi_][2] = MFMA(tf_, w2_, acc[mi_][2]); acc[mi_][3] = MFMA(tf_, w3_, acc[mi_][3]); } } while (0)
#define DOMM(tf_, tf1_, w0_, w1_, w2_, w3_) do { DOMM1(0, tf_, w0_, w1_, w2_, w3_); if (WM == 2) DOMM1(WM - 1, tf1_, w0_, w1_, w2_, w3_); } while (0)
      if (WM == 1) {
        LDFR(tfA, tfA1, wfA0, wfA1, wfA2, wfA3, 0);
        LDFR(tfB, tfB1, wfB0, wfB1, wfB2, wfB3, 1);
        PIN();
        DOMM(tfA, tfA1, wfA0, wfA1, wfA2, wfA3);
        PIN();
        LDFR(tfA, tfA1, wfA0, wfA1, wfA2, wfA3, 2);
        PIN();
        DOMM(tfB, tfB1, wfB0, wfB1, wfB2, wfB3);
        PIN();
        LDFR(tfB, tfB1, wfB0, wfB1, wfB2, wfB3, 3);
        PIN();
        DOMM(tfA, tfA1, wfA0, wfA1, wfA2, wfA3);
        DOMM(tfB, tfB1, wfB0, wfB1, wfB2, wfB3);
      } else {
        char* nb_ = smem + ((kt + 1 - kt0) & 1) * GBUF + lo;
#define MM2(mi_, tf_, wa_, wb_, na_, nb2_) do { if (SWAP) { acc[mi_][na_] = MFMA(wa_, tf_, acc[mi_][na_]); acc[mi_][nb2_] = MFMA(wb_, tf_, acc[mi_][nb2_]); } \
          else { acc[mi_][na_] = MFMA(tf_, wa_, acc[mi_][na_]); acc[mi_][nb2_] = MFMA(tf_, wb_, acc[mi_][nb2_]); } } while (0)
        LDFR(tfA, tfA1, wfA0, wfA1, wfA2, wfA3, 0);
        PIN();
        DOMM(tfA, tfA1, wfA0, wfA1, wfA2, wfA3);
        PIN();
        LDFR(tfA, tfA1, wfA0, wfA1, wfA2, wfA3, 1);
        PIN();
        DOMM(tfA, tfA1, wfA0, wfA1, wfA2, wfA3);
        PIN();
        LDFR(tfA, tfA1, wfA0, wfA1, wfA2, wfA3, 2);
        PIN();
        MM2(0, tfA, wfA0, wfA1, 0, 1); PIN(); *(uint4*)(nb_) = ra0; PIN();
        MM2(0, tfA, wfA2, wfA3, 2, 3); PIN(); *(uint4*)(nb_ + 64 * GSTR) = ra1; PIN();
        MM2(1, tfA1, wfA0, wfA1, 0, 1); PIN(); *(uint4*)(nb_ + 128 * GSTR) = ra2; PIN();
        MM2(1, tfA1, wfA2, wfA3, 2, 3); PIN(); *(uint4*)(nb_ + 192 * GSTR) = ra3; PIN();
        LDFR(tfA, tfA1, wfA0, wfA1, wfA2, wfA3, 3);
        PIN();
        MM2(0, tfA, wfA0, wfA1, 0, 1); PIN(); *(uint4*)(nb_ + 256 * GSTR) = rw0; PIN();
        MM2(0, tfA, wfA2, wfA3, 2, 3); PIN(); *(uint4*)(nb_ + 320 * GSTR) = rw1; PIN();
        MM2(1, tfA1, wfA0, wfA1, 0, 1); PIN(); *(uint4*)(nb_ + 384 * GSTR) = rw2; PIN();
        MM2(1, tfA1, wfA2, wfA3, 2, 3); PIN(); *(uint4*)(nb_ + 448 * GSTR) = rw3; PIN();
        GLOADG(kt + 2 < kt1 ? kt + 2 : kt);
#undef MM2
      }
#undef LDFR
#undef DOMM
#undef DOMM1
      PIN();
      if (WM == 1) { if (kt + 1 < kt1) SSTOREG(smem + ((kt + 1 - kt0) & 1) * GBUF); }
      __syncthreads();
    }
    const int cmt = mt, cnt = nt; const bool cpart = part;
    for (u += nslots; u < nunits; u += nslots) { UNIT_DECODE(u, mt, nt, kt0, kt1, part); if (!(skipctx && (mt % PT) == 0)) break; }
    if (u < nunits) { ap = A + (size_t)mt * 256 * K + (size_t)grow * K + gcol; wp = W + (size_t)nt * BN * K + (size_t)grow * K + gcol; GLOADG(kt0); }
    PIN();
#pragma unroll
    for (int mi = 0; mi < WM; ++mi) epi(acc[mi], __builtin_amdgcn_readfirstlane(cmt * 256 + (wm * WM + mi) * 32), __builtin_amdgcn_readfirstlane(cnt * WM + wn), lane, cpart);
  }
#undef GLOADG
#undef SSTOREG
#undef UNIT_DECODE
}

struct EpiX {
  const Params* p; const float* gate; float sc;
  DI void operator()(f32x16 (&acc)[4], int tok0, int nt, int lane, bool part = false) const {
    const int l31 = lane & 31, hh = lane >> 5;
    const int b = tok0 / PL, pp0 = tok0 - b * PL;
    const float* g = gate + (size_t)(pp0 < CTXL ? 4 : b) * 6144;
    float* xb = pp0 < CTXL ? (float*)(p->ws + OFF_CTXX) + (size_t)(b * CTXL + pp0) * DM : p->out + (size_t)(b * SEQ + pp0 - CTXL) * DM;
    float gv[4];
#pragma unroll
    for (int nb = 0; nb < 4; ++nb) gv[nb] = g[nt * 128 + nb * 32 + l31] * sc;
    float* xc = xb + nt * 128;
    const int loff = l31 + hh * 4 * DM;
    if (part) {
#pragma unroll
      for (int nb = 0; nb < 4; ++nb)
#pragma unroll
        for (int i = 0; i < 16; ++i) (void)__hip_atomic_fetch_add(xc + ((i & 3) + 8 * (i >> 2)) * DM + nb * 32 + loff, gv[nb] * acc[nb][i], __ATOMIC_RELAXED, __HIP_MEMORY_SCOPE_AGENT);
    } else {
      float xa[16], xb2[16];
#define XLD(dst_, nb_) _Pragma("unroll") for (int i = 0; i < 16; ++i) dst_[i] = (xc + ((i & 3) + 8 * (i >> 2)) * DM + (nb_) * 32)[loff]
#define XST(src_, nb_) _Pragma("unroll") for (int i = 0; i < 16; ++i) (xc + ((i & 3) + 8 * (i >> 2)) * DM + (nb_) * 32)[loff] = src_[i] + gv[nb_] * acc[nb_][i]
      XLD(xa, 0); XLD(xb2, 1); PIN();
      XST(xa, 0); PIN(); XLD(xa, 2); PIN();
      XST(xb2, 1); PIN(); XLD(xb2, 3); PIN();
      XST(xa, 2); PIN();
      XST(xb2, 3);
#undef XLD
#undef XST
    }
  }
};
struct EpiFfnUp {
  bf16_t* h;
  DI void operator()(f32x16 (&acc)[4], int tok0, int nt, int lane, bool part = false) const {
    const int l31 = lane & 31, hh = lane >> 5;
#pragma unroll
    for (int gg = 0; gg < 2; ++gg) {
      int col = (nt * 2 + gg) * 32 + l31;
#pragma unroll
      for (int i = 0; i < 16; ++i) {
        int row = tok0 + crow(i, hh);
        h[(size_t)row * DFF + col] = f2bf(siluf(acc[2 * gg][i]) * acc[2 * gg + 1][i]);
      }
    }
  }
};
struct EpiMlaIn {
  float* raw;
  DI void operator()(f32x16 (&acc)[4], int tok0, int nt, int lane, bool part = false) const {
    const int l31 = lane & 31, hh = lane >> 5;
#pragma unroll
    for (int nb = 0; nb < 4; ++nb) {
      int col = nt * 128 + nb * 32 + l31;
      if (col < 704) {
#pragma unroll
        for (int i = 0; i < 16; ++i) raw[(size_t)(tok0 + crow(i, hh)) * 704 + col] = acc[nb][i];
      }
    }
  }
};
struct EpiHgIn {
  char* ws;
  DI void operator()(f32x16 (&acc)[4], int tok0, int nt, int lane, bool part = false) const {
    const int l31 = lane & 31, hh = lane >> 5;
    const int sec = nt >> 3;
    bf16_t* dst = (bf16_t*)(ws + HG_Q + (size_t)sec * ACT16);
    const float* lb = (const float*)(ws + OFF_LB);
#pragma unroll
    for (int nb = 0; nb < 4; ++nb) {
      int col = (nt & 7) * 128 + nb * 32 + l31;
      float oml = 1.f;
      if (sec == 1) oml = 1.f - lb[col]; else if (sec == 2) oml = 1.f - lb[1024 + col];
#pragma unroll
      for (int i = 0; i < 16; ++i) {
        float v = acc[nb][i], o;
        if (sec == 1 || sec == 2) o = oml * sigmf(-v);
        else if (sec == 4) o = siluf(v);
        else o = v;
        dst[(size_t)(tok0 + crow(i, hh)) * DM + col] = f2bf(o);
      }
    }
  }
};

DI void store_block32_packed(uint2 (&o)[4], bf16_t* blk, int hh) {
#pragma unroll
  for (int k = 0; k < 4; k += 2) {
    const auto rx = __builtin_amdgcn_permlane32_swap(o[k].x, o[k + 1].x, false, false);
    const auto ry = __builtin_amdgcn_permlane32_swap(o[k].y, o[k + 1].y, false, false);
    *(uint4*)(blk + 8 * k + 8 * hh) = make_uint4(rx[0], ry[0], rx[1], ry[1]);
  }
}
DI void norm128_store(f32x16 (&acc)[4], const float* w, bf16_t* dst, int hh) {
  float ss = 0.f;
#pragma unroll
  for (int nb = 0; nb < 4; ++nb)
#pragma unroll
    for (int i = 0; i < 16; ++i) ss += acc[nb][i] * acc[nb][i];
  ss += __shfl_xor(ss, 32);
  float rs = rsqrtf(ss * (1.f / 128.f) + EPS);
#pragma unroll
  for (int nb = 0; nb < 4; ++nb) {
    uint2 o[4];
#pragma unroll
    for (int g = 0; g < 4; ++g) {
      int f = nb * 32 + 8 * g + 4 * hh;
      float4 wv4 = *(const float4*)(w + f);
      o[g].x = pk2(acc[nb][4 * g] * rs * wv4.x, acc[nb][4 * g + 1] * rs * wv4.y);
      o[g].y = pk2(acc[nb][4 * g + 2] * rs * wv4.z, acc[nb][4 * g + 3] * rs * wv4.w);
    }
    store_block32_packed(o, dst + nb * 32, hh);
  }
}
DI void norm64_rope_store(f32x16& a0, f32x16& a1, const float* w, bf16_t* dst, int hh, bool rope, int prow, int pcol, const float* cosT, const float* sinT) {
  float ss = 0.f;
#pragma unroll
  for (int i = 0; i < 16; ++i) ss += a0[i] * a0[i] + a1[i] * a1[i];
  ss += __shfl_xor(ss, 32);
  float rs = rsqrtf(ss * (1.f / 64.f) + EPS);
#pragma unroll
  for (int i = 0; i < 16; ++i) { int f = crow(i, hh); a0[i] = a0[i] * rs * w[f]; a1[i] = a1[i] * rs * w[32 + f]; }
  if (rope) {
#pragma unroll
    for (int i = 0; i < 8; ++i) {
      int j = crow(i, hh);
      float c0 = cosT[prow * 16 + j], s0 = sinT[prow * 16 + j], c1 = cosT[pcol * 16 + j], s1 = sinT[pcol * 16 + j];
      float t1 = a0[i], t2 = a0[i + 8];
      a0[i] = t1 * c0 - t2 * s0; a0[i + 8] = t2 * c0 + t1 * s0;
      float t3 = a1[i], t4 = a1[i + 8];
      a1[i] = t3 * c1 - t4 * s1; a1[i + 8] = t4 * c1 + t3 * s1;
    }
  }
  uint2 o0[4], o1[4];
#pragma unroll
  for (int g = 0; g < 4; ++g) {
    o0[g].x = pk2(a0[4 * g], a0[4 * g + 1]); o0[g].y = pk2(a0[4 * g + 2], a0[4 * g + 3]);
    o1[g].x = pk2(a1[4 * g], a1[4 * g + 1]); o1[g].y = pk2(a1[4 * g + 2], a1[4 * g + 3]);
  }
  store_block32_packed(o0, dst, hh);
  store_block32_packed(o1, dst + 32, hh);
}
DI void vt_store(f32x16 (&acc)[4], bf16_t* vt  , int pos0, int hh) {
  const int kq = pos0 & 15, pos = (pos0 & ~15) | (8 * ((kq >> 2) & 1) + (kq & 3) + 4 * (kq >> 3));
#pragma unroll
  for (int nb = 0; nb < 4; ++nb)
#pragma unroll
    for (int i = 0; i < 16; ++i) vt[(size_t)(nb * 32 + crow(i, hh)) * PL + pos] = f2bf(acc[nb][i]);
}

struct EpiMlaUq {
  char* ws; const float* qn_w; const float* qr_w;
  DI void operator()(f32x16 (&acc)[4], int tok0, int nt, int lane, bool part = false) const {
    const int l31 = lane & 31, hh = lane >> 5;
    const int b = tok0 / PL, pos = tok0 - b * PL + l31, pt = (pos < CTXL) ? 0 : 1;
    bf16_t* Q = (bf16_t*)(ws + MLA_Q);
    if (nt < 8) {
      norm128_store(acc, qn_w, Q + ((size_t)(b * 8 + nt) * PL + pos) * 192, hh);
    } else {
      const bool rope = pt != 0; const int t = pos - CTXL;
      const float* cosT = (const float*)(ws + OFF_COS); const float* sinT = (const float*)(ws + OFF_SIN);
      int h0 = (nt - 8) * 2;
      norm64_rope_store(acc[0], acc[1], qr_w, Q + ((size_t)(b * 8 + h0) * PL + pos) * 192 + 128, hh, rope, rope ? (t >> 6) : 0, rope ? (t & 63) : 0, cosT, sinT);
      norm64_rope_store(acc[2], acc[3], qr_w, Q + ((size_t)(b * 8 + h0 + 1) * PL + pos) * 192 + 128, hh, rope, rope ? (t >> 6) : 0, rope ? (t & 63) : 0, cosT, sinT);
    }
  }
};
struct EpiMlaUkv {
  char* ws; const float* kn_w;
  DI void operator()(f32x16 (&acc)[4], int tok0, int nt, int lane, bool part = false) const {
    const int l31 = lane & 31, hh = lane >> 5;
    const int b = tok0 / PL, pos = tok0 - b * PL + l31, head = nt >> 1;
    if ((nt & 1) == 0) norm128_store(acc, kn_w, (bf16_t*)(ws + MLA_K) + ((size_t)(b * 8 + head) * PL + pos) * 192, hh);
    else vt_store(acc, (bf16_t*)(ws + MLA_VT) + (size_t)(b * 8 + head) * 128 * PL, pos, hh);
  }
};
struct EpiDfQkv {
  char* ws; const float* qn_w; const float* kn_w;
  DI void operator()(f32x16 (&acc)[4], int tok0, int nt, int lane, bool part = false) const {
    const int l31 = lane & 31, hh = lane >> 5;
    const int b = tok0 / PL, pos = tok0 - b * PL + l31, pt = (pos < CTXL) ? 0 : 1;
    if (nt < 16) {
      const bool isq = nt < 8; const int head = nt & 7;
      bf16_t* dst = (bf16_t*)(ws + (isq ? DF_Q : DF_K));
      const float* w = isq ? qn_w : kn_w;
      const bool rope = pt != 0; const int t = pos - CTXL;
      const float* cosT = (const float*)(ws + OFF_COS); const float* sinT = (const float*)(ws + OFF_SIN);
      norm64_rope_store(acc[0], acc[1], w, dst + ((size_t)((b * 8 + head) * 2 + 0) * PL + pos) * 64, hh, rope, rope ? (t >> 6) : 0, rope ? (t & 63) : 0, cosT, sinT);
      norm64_rope_store(acc[2], acc[3], w, dst + ((size_t)((b * 8 + head) * 2 + 1) * PL + pos) * 64, hh, rope, rope ? (t >> 6) : 0, rope ? (t & 63) : 0, cosT, sinT);
    } else {
      vt_store(acc, (bf16_t*)(ws + DF_VT) + (size_t)(b * 8 + (nt - 16)) * 128 * PL, pos, hh);
    }
  }
};

DI void phase_mla_post(const Params& p, int j) {
  const int lane = TID() & 63, wv = TID() >> 6;
  const float* raw = (const float*)(p.ws + MLA_Q);
  bf16_t* cqn = (bf16_t*)(p.ws + MLA_CQN);
  bf16_t* ckvn = (bf16_t*)(p.ws + MLA_CKVN);
  bf16_t* Kb = (bf16_t*)(p.ws + MLA_K);
  const float* qnw = p.in[12] + j * 384; const float* kvnw = p.in[13] + j * 256; const float* krw = p.in[19] + j * 64;
  const float* cosT = (const float*)(p.ws + OFF_COS); const float* sinT = (const float*)(p.ws + OFF_SIN);
  for (int r = BID() * 8 + wv; r < NT; r += gridDim.x * 8) {
    const float* x = raw + (size_t)r * 704;
    float q[6], kv[4], kr;
    float sq = 0.f, skv = 0.f;
#pragma unroll
    for (int u = 0; u < 6; ++u) { q[u] = x[lane + 64 * u]; sq += q[u] * q[u]; }
#pragma unroll
    for (int u = 0; u < 4; ++u) { kv[u] = x[384 + lane + 64 * u]; skv += kv[u] * kv[u]; }
    kr = x[640 + lane];
    sq = wave_sum(sq); skv = wave_sum(skv);
    float skr = wave_sum(kr * kr);
    float rq = rsqrtf(sq * (1.f / 384.f) + EPS), rkv = rsqrtf(skv * (1.f / 256.f) + EPS), rkr = rsqrtf(skr * (1.f / 64.f) + EPS);
#pragma unroll
    for (int u = 0; u < 6; ++u) cqn[(size_t)r * 384 + lane + 64 * u] = f2bf(q[u] * rq * qnw[lane + 64 * u]);
#pragma unroll
    for (int u = 0; u < 4; ++u) ckvn[(size_t)r * 256 + lane + 64 * u] = f2bf(kv[u] * rkv * kvnw[lane + 64 * u]);
    float v = kr * rkr * krw[lane];
    int b = r / PL, pp = r - b * PL;
    float other = __shfl_xor(v, 16);
    if (pp >= CTXL) {
      int t = pp - CTXL, pos = (lane < 32) ? (t >> 6) : (t & 63), jf = lane & 15;
      float c = cosT[pos * 16 + jf], s = sinT[pos * 16 + jf];
      float rot = (lane & 16) ? other : -other;
      v = v * c + rot * s;
    }
    unsigned short vb = f2bf(v);
#pragma unroll
    for (int h = 0; h < 8; ++h) Kb[((size_t)(b * 8 + h) * PL + pp) * 192 + 128 + lane] = vb;
  }
}

template <int DQK, int NM>
DI void attn_item(const bf16_t* Qb, const bf16_t* Kb, size_t mstride, const bf16_t* VTb,
                  int q0, int nkt, float cs, bf16_t* Orow  , float lam, float outscale, const float* subw, char* smem) {
  constexpr int KSTR = DQK * 2 + 16, KT_BYTES = NM * 64 * KSTR, VSTR = 144, VT_BYTES = 128 * VSTR, BUF = KT_BYTES + VT_BYTES;
  constexpr int KCH = DQK / 8, NKC = NM * 64 * KCH / NTHR, WPM = 8 / NM, NS = DQK / 16;
  const int tid = TID(), lane = tid & 63, wv = tid >> 6, l31 = lane & 31, hh = lane >> 5;
  const int m = wv / WPM, wq = wv % WPM;
  const int qp = q0 + wq * 32 + l31;
  bf16x8 qf[NS];
  {
    const bf16_t* qptr = Qb + m * mstride + (size_t)qp * DQK + hh * 8;
#pragma unroll
    for (int s = 0; s < NS; ++s) qf[s] = *(const bf16x8*)(qptr + s * 16);
  }
  f32x16 oacc[4];
#pragma unroll
  for (int db = 0; db < 4; ++db)
#pragma unroll
    for (int i = 0; i < 16; ++i) oacc[db][i] = 0.f;
  float mrun = -1e30f, lrun = 0.f;
  uint4 kreg0, kreg1, kreg2, vreg0, vreg1;
  kreg2 = make_uint4(0, 0, 0, 0);
  int kgo[3], klo[3];
#pragma unroll
  for (int j = 0; j < 3; ++j) {
    int c = tid + NTHR * j, mm = c / (64 * KCH), rem = c - mm * (64 * KCH), row = rem / KCH, kc = rem - row * KCH;
    kgo[j] = row * DQK + kc * 8; klo[j] = (mm * 64 + row) * KSTR + kc * 16;
    if (NM == 2) kgo[j] += mm * (int)mstride;
  }
  const int vgo0 = (tid >> 3) * PL + (tid & 7) * 8, vgo1 = ((tid + NTHR) >> 3) * PL + (tid & 7) * 8;
  const int vlo0 = KT_BYTES + (tid >> 3) * VSTR + (tid & 7) * 16, vlo1 = KT_BYTES + ((tid + NTHR) >> 3) * VSTR + (tid & 7) * 16;
#define GLOAD(kt_) do { const bf16_t* kp_ = Kb + (size_t)(kt_) * 64 * DQK; const bf16_t* vp_ = VTb + (kt_) * 64; \
    kreg0 = *(const uint4*)(kp_ + kgo[0]); kreg1 = *(const uint4*)(kp_ + kgo[1]); if (NKC > 2) kreg2 = *(const uint4*)(kp_ + kgo[2]); \
    vreg0 = *(const uint4*)(vp_ + vgo0); vreg1 = *(const uint4*)(vp_ + vgo1); } while (0)
#define SSTORE(buf_) do { char* b_ = (buf_); \
    *(uint4*)(b_ + klo[0]) = kreg0; *(uint4*)(b_ + klo[1]) = kreg1; if (NKC > 2) *(uint4*)(b_ + klo[2]) = kreg2; \
    *(uint4*)(b_ + vlo0) = vreg0; *(uint4*)(b_ + vlo1) = vreg1; } while (0)
  GLOAD(0); SSTORE(smem); __syncthreads();
  for (int kt = 0; kt < nkt; ++kt) {
    const char* cur = smem + (kt & 1) * BUF;
    GLOAD(kt + 1 < nkt ? kt + 1 : kt);
    PIN();
    f32x16 sacc[2];
#pragma unroll
    for (int kb = 0; kb < 2; ++kb)
#pragma unroll
      for (int i = 0; i < 16; ++i) sacc[kb][i] = 0.f;
    const char* kbase = cur + (m * 64 + l31) * KSTR + hh * 16;
    {
      bf16x8 kfa[4], kfb[4];
#define KLD(dst_, s_) do { dst_[0] = *(const bf16x8*)(kbase + (s_) * 32); dst_[1] = *(const bf16x8*)(kbase + 32 * KSTR + (s_) * 32); \
        dst_[2] = *(const bf16x8*)(kbase + ((s_) + 1) * 32); dst_[3] = *(const bf16x8*)(kbase + 32 * KSTR + ((s_) + 1) * 32); } while (0)
#define KMM(src_, s_) do { sacc[0] = MFMA(src_[0], qf[s_], sacc[0]); sacc[1] = MFMA(src_[1], qf[s_], sacc[1]); \
        sacc[0] = MFMA(src_[2], qf[(s_) + 1], sacc[0]); sacc[1] = MFMA(src_[3], qf[(s_) + 1], sacc[1]); } while (0)
      KLD(kfa, 0);
#pragma unroll
      for (int g = 0; g < NS / 2; ++g) {
        PIN();
        if (g + 1 < NS / 2) { if (g & 1) KLD(kfa, 2 * g + 2); else KLD(kfb, 2 * g + 2); }
        PIN();
        if (g & 1) KMM(kfb, 2 * g); else KMM(kfa, 2 * g);
      }
#undef KLD
#undef KMM
    }
    float mx = sacc[0][0];
#pragma unroll
    for (int i = 1; i < 16; ++i) mx = fmaxf(mx, sacc[0][i]);
#pragma unroll
    for (int i = 0; i < 16; ++i) mx = fmaxf(mx, sacc[1][i]);
    {
      const auto rr = __builtin_amdgcn_permlane32_swap(__float_as_uint(mx), __float_as_uint(mx), false, false);
      mx = fmaxf(__uint_as_float(rr[0]), __uint_as_float(rr[1]));
    }
    if (__any((mx - mrun) * cs > 8.f)) {
      const float mnew = fmaxf(mrun, mx);
      const float alpha = __builtin_amdgcn_exp2f((mrun - mnew) * cs);
      mrun = mnew;
      lrun *= alpha;
#pragma unroll
      for (int db = 0; db < 4; ++db)
#pragma unroll
        for (int i = 0; i < 16; ++i) oacc[db][i] *= alpha;
    }
    {
      const f32x2_t cs2 = {cs, cs}, mc2 = {mrun * cs, mrun * cs};
      f32x2_t ps2 = {0.f, 0.f};
#pragma unroll
      for (int kb = 0; kb < 2; ++kb)
#pragma unroll
        for (int i = 0; i < 16; i += 2) {
          f32x2_t t = {sacc[kb][i], sacc[kb][i + 1]};
          t = t * cs2 - mc2;
          t.x = __builtin_amdgcn_exp2f(t.x); t.y = __builtin_amdgcn_exp2f(t.y);
          sacc[kb][i] = t.x; sacc[kb][i + 1] = t.y;
          ps2 = ps2 + t;
        }
      lrun += ps2.x + ps2.y;
    }
    const char* vbase = cur + KT_BYTES + l31 * VSTR + hh * 16;
    {
      struct VF { bf16x8 v; };
      VF vfa[4], vfb[4];
#define VLD(dst_, s4_) do { _Pragma("unroll") for (int db = 0; db < 4; ++db) dst_[db].v = *(const bf16x8*)(vbase + db * 32 * VSTR + (s4_) * 32); } while (0)
      VLD(vfa, 0);
#pragma unroll
      for (int s4 = 0; s4 < 4; ++s4) {
        const int kb = s4 >> 1, sp = s4 & 1;
        PIN();
        if (s4 < 3) { if (s4 & 1) VLD(vfa, s4 + 1); else VLD(vfb, s4 + 1); }
        union { bf16x8 v; unsigned u[4]; } pf;
#pragma unroll
        for (int e = 0; e < 4; ++e) pf.u[e] = pk2(sacc[kb][8 * sp + 2 * e], sacc[kb][8 * sp + 2 * e + 1]);
        PIN();
#pragma unroll
        for (int db = 0; db < 4; ++db) { if (s4 & 1) oacc[db] = MFMA(vfb[db].v, pf.v, oacc[db]); else oacc[db] = MFMA(vfa[db].v, pf.v, oacc[db]); }
        {
          char* b_ = smem + ((kt + 1) & 1) * BUF;
          if (s4 == 0) { *(uint4*)(b_ + klo[0]) = kreg0; if (NKC > 2) *(uint4*)(b_ + klo[2]) = kreg2; }
          if (s4 == 1) { *(uint4*)(b_ + klo[1]) = kreg1; }
          if (s4 == 2) { *(uint4*)(b_ + vlo0) = vreg0; }
          if (s4 == 3) { *(uint4*)(b_ + vlo1) = vreg1; }
        }
      }
#undef VLD
    }
    PIN();
    __syncthreads();
  }
#undef GLOAD
#undef SSTORE
  lrun += __shfl_xor(lrun, 32);
  const float inv = 1.f / lrun;
#pragma unroll
  for (int db = 0; db < 4; ++db)
#pragma unroll
    for (int i = 0; i < 16; ++i) oacc[db][i] *= inv;
  if (NM == 2) {
    float* cb = (float*)smem;
    if (m == 1) {
#pragma unroll
      for (int db = 0; db < 4; ++db)
#pragma unroll
        for (int i = 0; i < 16; ++i) cb[(wq * 64 + db * 16 + i) * 64 + lane] = oacc[db][i];
    }
    __syncthreads();
    if (m == 0) {
      float ss = 0.f;
#pragma unroll
      for (int db = 0; db < 4; ++db)
#pragma unroll
        for (int i = 0; i < 16; ++i) { float o = oacc[db][i] - lam * cb[(wq * 64 + db * 16 + i) * 64 + lane]; oacc[db][i] = o; ss += o * o; }
      ss += __shfl_xor(ss, 32);
      const float rs = rsqrtf(ss * (1.f / 128.f) + EPS) * outscale;
#pragma unroll
      for (int db = 0; db < 4; ++db)
#pragma unroll
        for (int g = 0; g < 4; ++g) {
          int d = db * 32 + 8 * g + 4 * hh;
          float4 w4 = *(const float4*)(subw + d);
          uint2 o;
          o.x = pk2(oacc[db][4 * g] * rs * w4.x, oacc[db][4 * g + 1] * rs * w4.y);
          o.y = pk2(oacc[db][4 * g + 2] * rs * w4.z, oacc[db][4 * g + 3] * rs * w4.w);
          *(uint2*)(Orow + (size_t)qp * DM + d) = o;
        }
    }
    __syncthreads();
  } else {
#pragma unroll
    for (int db = 0; db < 4; ++db) {
      uint2 o[4];
#pragma unroll
      for (int g = 0; g < 4; ++g) { o[g].x = pk2(oacc[db][4 * g], oacc[db][4 * g + 1]); o[g].y = pk2(oacc[db][4 * g + 2], oacc[db][4 * g + 3]); }
      store_block32_packed(o, Orow + (size_t)qp * DM + db * 32, hh);
    }
  }
}

DI void attn_item_df2(const bf16_t* Qb, const bf16_t* Kb, size_t mstride, const bf16_t* VTb, int q0, int nkt  , float cs,
                      bf16_t* Orow, float lam, float outscale, const float* subw, char* smem) {
  constexpr int DQK = 64, KSTR = 144, KT_BYTES = 2 * 64 * KSTR, VSTR = 144, VT_BYTES = 128 * VSTR;
  const int tid = TID(), lane = tid & 63, wv = tid >> 6, l31 = lane & 31, hh = lane >> 5;
  const int m = wv >> 2, wq = wv & 3;
  const int qp = q0 + wq * 32 + l31;
  bf16x8 qf[4];
  {
    const bf16_t* qptr = Qb + m * mstride + (size_t)qp * DQK + hh * 8;
#pragma unroll
    for (int s = 0; s < 4; ++s) qf[s] = *(const bf16x8*)(qptr + s * 16);
  }
  f32x16 oacc[4];
#pragma unroll
  for (int db = 0; db < 4; ++db)
#pragma unroll
    for (int i = 0; i < 16; ++i) oacc[db][i] = 0.f;
  float mrun = -1e30f, lrun = 0.f;
  uint4 kreg0, kreg1, vreg0, vreg1;
  const int c1 = tid + NTHR;
  const int kgo0 = (tid >> 9) * (int)mstride + ((tid & 511) >> 3) * DQK + (tid & 7) * 8, kgo1 = (c1 >> 9) * (int)mstride + ((c1 & 511) >> 3) * DQK + (c1 & 7) * 8;
  const int klo0 = ((tid >> 9) * 64 + ((tid & 511) >> 3)) * KSTR + (tid & 7) * 16, klo1 = ((c1 >> 9) * 64 + ((c1 & 511) >> 3)) * KSTR + (c1 & 7) * 16;
  const int vgo0 = (tid >> 3) * PL + (tid & 7) * 8, vgo1 = (c1 >> 3) * PL + (tid & 7) * 8;
  const int vlo0 = (tid >> 3) * VSTR + (tid & 7) * 16, vlo1 = (c1 >> 3) * VSTR + (tid & 7) * 16;
  const int kfo = (m * 64 + l31) * KSTR + hh * 16;
  const int vfo = 2 * KT_BYTES + l31 * VSTR + hh * 16;
  union PF { bf16x8 v; unsigned u[4]; };
  PF pf[4];
  f32x16 pA[2], pB[2];
#define D2_GLOAD(t_) do { const bf16_t* kp_ = Kb + (size_t)(t_) * 64 * DQK; const bf16_t* vp_ = VTb + (t_) * 64; \
    kreg0 = *(const uint4*)(kp_ + kgo0); kreg1 = *(const uint4*)(kp_ + kgo1); vreg0 = *(const uint4*)(vp_ + vgo0); vreg1 = *(const uint4*)(vp_ + vgo1); } while (0)
#define D2_SSTORE(ks_, vs_) do { char* kb_ = smem + (ks_) * KT_BYTES; char* vb_ = smem + 2 * KT_BYTES + (vs_) * VT_BYTES; \
    *(uint4*)(kb_ + klo0) = kreg0; *(uint4*)(kb_ + klo1) = kreg1; *(uint4*)(vb_ + vlo0) = vreg0; *(uint4*)(vb_ + vlo1) = vreg1; } while (0)
#define D2_RESCALE(mx_) do { if (__any(((mx_) - mrun) * cs > 8.f)) { const float mnew = fmaxf(mrun, (mx_)); const float alpha = __builtin_amdgcn_exp2f((mrun - mnew) * cs); \
      mrun = mnew; lrun *= alpha; \
      _Pragma("unroll") for (int db = 0; db < 4; ++db) _Pragma("unroll") for (int i = 0; i < 16; ++i) oacc[db][i] *= alpha; } } while (0)
#define D2_HALFMAX(mx_) do { const auto rr_ = __builtin_amdgcn_permlane32_swap(__float_as_uint(mx_), __float_as_uint(mx_), false, false); \
      mx_ = fmaxf(__uint_as_float(rr_[0]), __uint_as_float(rr_[1])); } while (0)
#define D2_FIN(prev_, step_) do { const int kbp_ = (step_) >> 2, ii_ = ((step_) & 3) * 4; \
      f32x2_t t0_ = {prev_[kbp_][ii_], prev_[kbp_][ii_ + 1]}, t1_ = {prev_[kbp_][ii_ + 2], prev_[kbp_][ii_ + 3]}; \
      t0_ = t0_ * cs2 - mc2; t1_ = t1_ * cs2 - mc2; \
      t0_.x = __builtin_amdgcn_exp2f(t0_.x); t0_.y = __builtin_amdgcn_exp2f(t0_.y); t1_.x = __builtin_amdgcn_exp2f(t1_.x); t1_.y = __builtin_amdgcn_exp2f(t1_.y); \
      ps2 = ps2 + t0_; ps2 = ps2 + t1_; \
      pf[2 * kbp_ + (ii_ >> 3)].u[(ii_ & 7) >> 1] = pk2(t0_.x, t0_.y); pf[2 * kbp_ + (ii_ >> 3)].u[((ii_ & 7) >> 1) + 1] = pk2(t1_.x, t1_.y); } while (0)
#define D2_SEG_A(cur_, prev_, ks_, FIN_) do { \
      const char* kb_ = smem + (ks_) * KT_BYTES + kfo; bf16x8 kf_[8]; \
      _Pragma("unroll") for (int st_ = 0; st_ < 8; ++st_) kf_[st_] = *(const bf16x8*)(kb_ + (st_ & 1) * 32 * KSTR + (st_ >> 1) * 32); \
      _Pragma("unroll") for (int kb2_ = 0; kb2_ < 2; ++kb2_) _Pragma("unroll") for (int i = 0; i < 16; ++i) cur_[kb2_][i] = 0.f; \
      _Pragma("unroll") for (int st_ = 0; st_ < 8; ++st_) { \
        PIN(); \
        cur_[st_ & 1] = MFMA(kf_[st_], qf[st_ >> 1], cur_[st_ & 1]); \
        if (FIN_ && (st_ & 1) == 0) { D2_FIN(prev_, (st_ >> 1)); } \
      } \
      PIN(); } while (0)
#define D2_SEG_B(cur_, prev_, vs_, MAX_, FIN2_, ST_, kns_, vns_, mx_) do { \
      const char* vb_ = smem + vfo + (vs_) * VT_BYTES; bf16x8 vfa_[4], vfb_[4]; \
      _Pragma("unroll") for (int db = 0; db < 4; ++db) vfa_[db] = *(const bf16x8*)(vb_ + db * 32 * VSTR); \
      _Pragma("unroll") for (int s4 = 0; s4 < 4; ++s4) { \
        PIN(); \
        if (s4 < 3) { _Pragma("unroll") for (int db = 0; db < 4; ++db) { if (s4 & 1) vfa_[db] = *(const bf16x8*)(vb_ + db * 32 * VSTR + (s4 + 1) * 32); else vfb_[db] = *(const bf16x8*)(vb_ + db * 32 * VSTR + (s4 + 1) * 32); } } \
        PIN(); \
        _Pragma("unroll") for (int db = 0; db < 4; ++db) { \
          if (s4 & 1) oacc[db] = MFMA(vfb_[db], pf[s4].v, oacc[db]); else oacc[db] = MFMA(vfa_[db], pf[s4].v, oacc[db]); \
          if (FIN2_ && s4 < 2 && (db & 1) == 0) { PIN(); D2_FIN(prev_, 4 + 2 * s4 + (db >> 1)); PIN(); } \
          if (MAX_ && s4 >= 2 && (db & 1) == 0) { PIN(); _Pragma("unroll") for (int i = 0; i < 8; ++i) mx_ = fmaxf(mx_, cur_[s4 - 2][(db >> 1) * 8 + i]); PIN(); } \
        } \
        if (ST_) { char* kw_ = smem + (kns_) * KT_BYTES; char* vw_ = smem + 2 * KT_BYTES + (vns_) * VT_BYTES; \
          if (s4 == 0) *(uint4*)(kw_ + klo0) = kreg0; if (s4 == 1) *(uint4*)(kw_ + klo1) = kreg1; \
          if (s4 == 2) *(uint4*)(vw_ + vlo0) = vreg0; if (s4 == 3) *(uint4*)(vw_ + vlo1) = vreg1; } \
      } \
      PIN(); } while (0)
#define D2_ITER(j_, cur_, prev_) do { \
      D2_GLOAD((j_) + 1 < nkt ? (j_) + 1 : (j_)); PIN(); \
      const f32x2_t cs2 = {cs, cs}, mc2 = {mrun * cs, mrun * cs}; f32x2_t ps2 = {0.f, 0.f}; \
      D2_SEG_A(cur_, prev_, (j_) & 1, true); \
      float mx_ = -1e30f; const int v1_ = vs0 == 2 ? 0 : vs0 + 1, v2_ = v1_ == 2 ? 0 : v1_ + 1; \
      D2_SEG_B(cur_, prev_, vs0, true, true, true, ((j_) + 1) & 1, v2_, mx_); \
      lrun += ps2.x + ps2.y; \
      D2_HALFMAX(mx_); D2_RESCALE(mx_); \
      vs0 = v1_; \
      __syncthreads(); } while (0)
  int vs0 = 0;
  D2_GLOAD(0); D2_SSTORE(0, 0); __syncthreads();
  D2_GLOAD(1); PIN();
  { const f32x2_t cs2 = {cs, cs}, mc2 = {0.f, 0.f}; f32x2_t ps2 = {0.f, 0.f}; D2_SEG_A(pA, pB, 0, false); (void)cs2; (void)mc2; (void)ps2; }
  { float mx0 = pA[0][0];
#pragma unroll
    for (int i = 1; i < 16; ++i) mx0 = fmaxf(mx0, pA[0][i]);
#pragma unroll
    for (int i = 0; i < 16; ++i) mx0 = fmaxf(mx0, pA[1][i]);
    D2_HALFMAX(mx0); D2_RESCALE(mx0); }
  PIN();
  D2_SSTORE(1, 1);
  __syncthreads();
  for (int j = 1; j < nkt - 1; j += 2) {
    D2_ITER(j, pB, pA);
    D2_ITER(j + 1, pA, pB);
  }
  D2_ITER(nkt - 1, pB, pA);
  {
    const f32x2_t cs2 = {cs, cs}, mc2 = {mrun * cs, mrun * cs}; f32x2_t ps2 = {0.f, 0.f};
#pragma unroll
    for (int st = 0; st < 8; ++st) { D2_FIN(pB, st); }
    lrun += ps2.x + ps2.y;
    float mxd = 0.f;
    D2_SEG_B(pB, pB, vs0, false, false, false, 0, 0, mxd);
  }
  __syncthreads();
#undef D2_GLOAD
#undef D2_SSTORE
#undef D2_RESCALE
#undef D2_HALFMAX
#undef D2_FIN
#undef D2_SEG_A
#undef D2_SEG_B
#undef D2_ITER
  lrun += __shfl_xor(lrun, 32);
  const float inv = 1.f / lrun;
#pragma unroll
  for (int db = 0; db < 4; ++db)
#pragma unroll
    for (int i = 0; i < 16; ++i) oacc[db][i] *= inv;
  float* cb = (float*)smem;
  if (m == 1) {
#pragma unroll
    for (int db = 0; db < 4; ++db)
#pragma unroll
      for (int i = 0; i < 16; ++i) cb[(wq * 64 + db * 16 + i) * 64 + lane] = oacc[db][i];
  }
  __syncthreads();
  if (m == 0) {
    float ss = 0.f;
#pragma unroll
    for (int db = 0; db < 4; ++db)
#pragma unroll
      for (int i = 0; i < 16; ++i) { float o = oacc[db][i] - lam * cb[(wq * 64 + db * 16 + i) * 64 + lane]; oacc[db][i] = o; ss += o * o; }
    ss += __shfl_xor(ss, 32);
    const float rs = rsqrtf(ss * (1.f / 128.f) + EPS) * outscale;
#pragma unroll
    for (int db = 0; db < 4; ++db) {
      uint2 o[4];
#pragma unroll
      for (int g = 0; g < 4; ++g) {
        int d = db * 32 + 8 * g + 4 * hh;
        float4 w4 = *(const float4*)(subw + d);
        o[g].x = pk2(oacc[db][4 * g] * rs * w4.x, oacc[db][4 * g + 1] * rs * w4.y);
        o[g].y = pk2(oacc[db][4 * g + 2] * rs * w4.z, oacc[db][4 * g + 3] * rs * w4.w);
      }
      store_block32_packed(o, Orow + (size_t)qp * DM + db * 32, hh);
    }
  }
  __syncthreads();
}

DI void phase_attn_mla(const Params& p, bool do_ctx, char* smem) {
  const bf16_t* Q = (const bf16_t*)(p.ws + MLA_Q); const bf16_t* K = (const bf16_t*)(p.ws + MLA_K); const bf16_t* VT = (const bf16_t*)(p.ws + MLA_VT);
  bf16_t* O = (bf16_t*)(p.ws + OFF_ABUF);
  const float cs = 1.4426950408889634f / sqrtf(192.f);
  const int xcd = BID() & 7, slot = BID() >> 3, nslots = gridDim.x >> 3;
  for (int q = slot; q < 4 * 32; q += nslots) {
    int bh = (q >> 5) * 8 + xcd, qb = (q & 31) + 1;
    int b = bh >> 3, h = bh & 7;
    attn_item<192, 1>(Q + (size_t)bh * PL * 192, K + (size_t)bh * PL * 192, 0, VT + (size_t)bh * 128 * PL, qb * 256, PL / 64, cs,
                      O + (size_t)b * PL * DM + h * 128, 0.f, 1.f, nullptr, smem);
  }
  if (do_ctx) {
    for (int bh = BID(); bh < 32; bh += gridDim.x) {
      int b = bh >> 3, h = bh & 7;
      attn_item<192, 1>(Q + (size_t)bh * PL * 192, K + (size_t)bh * PL * 192, 0, VT + (size_t)bh * 128 * PL, 0, CTXL / 64, cs,
                        O + (size_t)b * PL * DM + h * 128, 0.f, 1.f, nullptr, smem);
    }
  }
}

DI void phase_attn_df(const Params& p, bool do_ctx, char* smem) {
  const bf16_t* Q = (const bf16_t*)(p.ws + DF_Q); const bf16_t* K = (const bf16_t*)(p.ws + DF_K); const bf16_t* VT = (const bf16_t*)(p.ws + DF_VT);
  bf16_t* O = (bf16_t*)(p.ws + OFF_ABUF);
  const float cs = 1.4426950408889634f / sqrtf(64.f);
  const float lam = *(const float*)(p.ws + OFF_LAM);
  const float lam_init = 0.8f - 0.6f * expf(-0.3f * 2.f);
  const float* subw = p.in[29];
  const int xcd = BID() & 7, slot = BID() >> 3, nslots = gridDim.x >> 3;
  for (int q = slot; q < 4 * 64; q += nslots) {
    int bh = (q >> 6) * 8 + xcd, qb = (q & 63) + 2;
    int b = bh >> 3, h = bh & 7;
    attn_item_df2(Q + (size_t)bh * 2 * PL * 64, K + (size_t)bh * 2 * PL * 64, (size_t)PL * 64, VT + (size_t)bh * 128 * PL, qb * 128, PL / 64, cs,
                     O + (size_t)b * PL * DM + h * 128, lam, 1.f - lam_init, subw, smem);
  }
  if (do_ctx) {
    for (int it = BID(); it < 64; it += gridDim.x) {
      int bh = it >> 1, qb = it & 1;
      int b = bh >> 3, h = bh & 7;
      attn_item_df2(Q + (size_t)bh * 2 * PL * 64, K + (size_t)bh * 2 * PL * 64, (size_t)PL * 64, VT + (size_t)bh * 128 * PL, qb * 128, CTXL / 64, cs,
                       O + (size_t)b * PL * DM + h * 128, lam, 1.f - lam_init, subw, smem);
    }
  }
}

constexpr int SC_T = 32;
constexpr int SC_BUF = SC_T * 128 * 4 * 2 + SC_T * 32 * 4;
DI float dpp_row_sum16(float v) {
  v += __int_as_float(__builtin_amdgcn_update_dpp(0, __float_as_int(v), 0xB1, 0xF, 0xF, true));
  v += __int_as_float(__builtin_amdgcn_update_dpp(0, __float_as_int(v), 0x4E, 0xF, 0xF, true));
  v += __int_as_float(__builtin_amdgcn_update_dpp(0, __float_as_int(v), 0x141, 0xF, 0xF, true));
  v += __int_as_float(__builtin_amdgcn_update_dpp(0, __float_as_int(v), 0x140, 0xF, 0xF, true));
  return v;
}
DI void phase_hg_scan(const Params& p, char* smem) {
  const int tid = TID(), lane = tid & 63, wv = tid >> 6;
  const int dpart = lane & 15, esub = lane >> 4, el = wv * 4 + esub;
  const bf16_t* qb = (const bf16_t*)(p.ws + HG_Q);
  const bf16_t* ib = (const bf16_t*)(p.ws + HG_I);
  const int ltok = tid >> 4, ldc = tid & 15;
  const int vtok = (tid & 127) >> 2, vec = tid & 3;
  for (int item = BID(); item < 256; item += gridDim.x) {
    const int b = item >> 6, h = (item >> 3) & 7, dir = (item >> 2) & 1, eq = item & 3;
    const bf16_t* kk = (const bf16_t*)(p.ws + (dir ? HG_KB : HG_KF));
    bf16_t* oo = (bf16_t*)(p.ws + (dir ? HG_OB : OFF_ABUF));
    const size_t rowbase = (size_t)b * PL;
    const int colq = h * 128 + ldc * 8, colv = h * 128 + eq * 32 + vec * 8, colo = h * 128 + eq * 32 + el;
    auto posf = [&](int tau) { return dir ? (tau < CTXL ? CTXL - 1 - tau : PL - 1 - (tau - CTXL)) : tau; };
    f32x2_t S[4];
#pragma unroll
    for (int j = 0; j < 4; ++j) S[j] = f32x2_t{0.f, 0.f};
    uint4 aq, ak, av, bq, bk, bv;
    av = make_uint4(0, 0, 0, 0); bv = av;
#define SC_LOAD(rq_, rk_, rv_, c_) do { const size_t r_ = rowbase + posf((c_) * SC_T + ltok); \
      rq_ = *(const uint4*)(qb + r_ * DM + colq); rk_ = *(const uint4*)(kk + r_ * DM + colq); \
      if (tid < 128) { const size_t r2_ = rowbase + posf((c_) * SC_T + vtok); rv_ = *(const uint4*)(ib + r2_ * DM + colv); } } while (0)
#define SC_UNPK(dst_, u_) do { float4 lo_, hi_; lo_.x = __uint_as_float((u_).x << 16); lo_.y = __uint_as_float((u_).x & 0xffff0000u); lo_.z = __uint_as_float((u_).y << 16); lo_.w = __uint_as_float((u_).y & 0xffff0000u); \
      hi_.x = __uint_as_float((u_).z << 16); hi_.y = __uint_as_float((u_).z & 0xffff0000u); hi_.z = __uint_as_float((u_).w << 16); hi_.w = __uint_as_float((u_).w & 0xffff0000u); \
      *(float4*)(dst_) = lo_; *(float4*)((dst_) + 4) = hi_; } while (0)
#define SC_STORE(rq_, rk_, rv_, buf_) do { float* fb_ = (float*)(buf_); SC_UNPK(fb_ + ltok * 128 + ldc * 8, rq_); SC_UNPK(fb_ + SC_T * 128 + ltok * 128 + ldc * 8, rk_); \
      if (tid < 128) SC_UNPK(fb_ + 2 * SC_T * 128 + vtok * 32 + vec * 8, rv_); } while (0)
#define SC_COMPUTE(buf_, c_) do { const float* fb_ = (const float*)(buf_); \
      for (int t0_ = 0; t0_ < SC_T; t0_ += 16) { \
        float keep_ = 0.f; \
        _Pragma("unroll") for (int u_ = 0; u_ < 16; ++u_) { const int t_ = t0_ + u_; \
          const float4 q0_ = *(const float4*)(fb_ + t_ * 128 + dpart * 8), q1_ = *(const float4*)(fb_ + t_ * 128 + dpart * 8 + 4); \
          const float4 k0_ = *(const float4*)(fb_ + SC_T * 128 + t_ * 128 + dpart * 8), k1_ = *(const float4*)(fb_ + SC_T * 128 + t_ * 128 + dpart * 8 + 4); \
          const float v_ = fb_[2 * SC_T * 128 + t_ * 32 + el]; const f32x2_t v2_ = {v_, v_}; \
          const f32x2_t kk0_ = {k0_.x, k0_.y}, kk1_ = {k0_.z, k0_.w}, kk2_ = {k1_.x, k1_.y}, kk3_ = {k1_.z, k1_.w}; \
          const f32x2_t qq0_ = {q0_.x, q0_.y}, qq1_ = {q0_.z, q0_.w}, qq2_ = {q1_.x, q1_.y}, qq3_ = {q1_.z, q1_.w}; \
          S[0] = S[0] + kk0_ * (v2_ - S[0]); S[1] = S[1] + kk1_ * (v2_ - S[1]); S[2] = S[2] + kk2_ * (v2_ - S[2]); S[3] = S[3] + kk3_ * (v2_ - S[3]); \
          f32x2_t pp_ = S[0] * qq0_; pp_ = pp_ + S[1] * qq1_; pp_ = pp_ + S[2] * qq2_; pp_ = pp_ + S[3] * qq3_; \
          const float part_ = dpp_row_sum16(pp_.x + pp_.y); \
          keep_ = (dpart == u_) ? part_ : keep_; \
        } \
        oo[(rowbase + posf((c_) * SC_T + t0_ + dpart)) * DM + colo] = f2bf(keep_); \
      } } while (0)
    constexpr int NCH = PL / SC_T;
    SC_LOAD(aq, ak, av, 0); SC_STORE(aq, ak, av, smem);
    SC_LOAD(aq, ak, av, 1);
    __syncthreads();
    for (int c = 0; c < NCH; c += 2) {
      SC_LOAD(bq, bk, bv, (c + 2 < NCH ? c + 2 : c));
      PIN();
      SC_COMPUTE(smem, c);
      PIN();
      SC_STORE(aq, ak, av, smem + SC_BUF);
      __syncthreads();
      SC_LOAD(aq, ak, av, (c + 3 < NCH ? c + 3 : c));
      PIN();
      SC_COMPUTE(smem + SC_BUF, c + 1);
      PIN();
      SC_STORE(bq, bk, bv, smem);
      __syncthreads();
    }
#undef SC_LOAD
#undef SC_UNPK
#undef SC_STORE
#undef SC_COMPUTE
  }
}

DI void phase_hg_readout(const Params& p, int j) {
  const int lane = TID() & 63, wv = TID() >> 6;
  bf16_t* of = (bf16_t*)(p.ws + OFF_ABUF);
  const bf16_t* ob = (const bf16_t*)(p.ws + HG_OB);
  const bf16_t* sg = (const bf16_t*)(p.ws + HG_G);
  const float* onw = p.in[23] + j * 128;
  for (int r = BID() * 8 + wv; r < NT; r += gridDim.x * 8) {
    const size_t base = (size_t)r * DM + lane * 16;
    uint4 a[2], bq[2], g[2];
    a[0] = *(const uint4*)(of + base); a[1] = *(const uint4*)(of + base + 8);
    bq[0] = *(const uint4*)(ob + base); bq[1] = *(const uint4*)(ob + base + 8);
    g[0] = *(const uint4*)(sg + base); g[1] = *(const uint4*)(sg + base + 8);
    float o[16], gg[16];
#pragma unroll
    for (int u = 0; u < 2; ++u) {
      const unsigned aw[4] = {a[u].x, a[u].y, a[u].z, a[u].w}, bw[4] = {bq[u].x, bq[u].y, bq[u].z, bq[u].w}, gw[4] = {g[u].x, g[u].y, g[u].z, g[u].w};
#pragma unroll
      for (int c = 0; c < 4; ++c) {
        o[u * 8 + 2 * c] = __uint_as_float(aw[c] << 16) + __uint_as_float(bw[c] << 16);
        o[u * 8 + 2 * c + 1] = __uint_as_float(aw[c] & 0xffff0000u) + __uint_as_float(bw[c] & 0xffff0000u);
        gg[u * 8 + 2 * c] = __uint_as_float(gw[c] << 16);
        gg[u * 8 + 2 * c + 1] = __uint_as_float(gw[c] & 0xffff0000u);
      }
    }
    float ss = 0.f;
#pragma unroll
    for (int c = 0; c < 16; ++c) ss += o[c] * o[c];
    ss += __shfl_xor(ss, 1); ss += __shfl_xor(ss, 2); ss += __shfl_xor(ss, 4);
    const float rs = rsqrtf(ss * (1.f / 128.f) + EPS);
    const int d0 = (lane & 7) * 16;
    unsigned ow[8];
#pragma unroll
    for (int c = 0; c < 8; ++c) ow[c] = pk2(o[2 * c] * rs * onw[d0 + 2 * c] * gg[2 * c], o[2 * c + 1] * rs * onw[d0 + 2 * c + 1] * gg[2 * c + 1]);
    *(uint4*)(of + base) = make_uint4(ow[0], ow[1], ow[2], ow[3]);
    *(uint4*)(of + base + 8) = make_uint4(ow[4], ow[5], ow[6], ow[7]);
  }
}


#define XB_TMO      128
#define XB_XCNT(j)  (256  + 64 * (j))
#define XB_XSUB(j)  (1280 + 64 * (j))
#define XB_XGEN(j)  (2304 + 64 * (j))
#define XB_TOP      3328
#define XB_TOPGEN   3392
#define XCD_BAR_WORDS 3456
#define XB_SPIN_CAP (1u << 20)
#define LAS __attribute__((address_space(3)))
DI unsigned xb_ld(unsigned* p)              { return __hip_atomic_load(p, __ATOMIC_RELAXED, __HIP_MEMORY_SCOPE_AGENT); }
DI unsigned xb_add(unsigned* p, unsigned v) { return __hip_atomic_fetch_add(p, v, __ATOMIC_RELAXED, __HIP_MEMORY_SCOPE_AGENT); }
DI unsigned xb_xcc_id() { return (unsigned)__builtin_amdgcn_s_getreg((3 << 11) | 20) & 0xFu; }
#define XB_SPIN(cond, bar) do { unsigned _sp = 0; while (cond) { __builtin_amdgcn_s_sleep(1); \
    if ((++_sp & 255u) == 0u) { if (xb_ld(&(bar)[XB_TMO])) break; if (_sp > XB_SPIN_CAP) { atomicAdd(&(bar)[XB_TMO], 1u); break; } } } } while (0)
struct XcdBarrier { unsigned* bar; unsigned x; volatile LAS unsigned* st; };
DI XcdBarrier xcd_barrier_post(unsigned* bar, volatile LAS unsigned* st) {
  XcdBarrier b; b.bar = bar; b.x = xb_xcc_id(); b.st = st;
  if (threadIdx.x == 0) (void)xb_add(&bar[XB_XCNT(b.x)], 1u);
  return b;
}
DI void xcd_barrier_complete(unsigned* bar, unsigned x, unsigned& nloc, unsigned& nx) {
  const unsigned G = gridDim.x * gridDim.y * gridDim.z;
  unsigned sum, cnt, mine, sp = 0u;
  for (;;) {
    sum = 0u; cnt = 0u; mine = 0u;
#pragma unroll
    for (unsigned j = 0; j < 16; ++j) { const unsigned c = xb_ld(&bar[XB_XCNT(j)]); sum += c; cnt += (c > 0u) ? 1u : 0u; mine = (j == x) ? c : mine; }
    if (sum == G) break;
    __builtin_amdgcn_s_sleep(1);
    if ((++sp & 255u) == 0u) { if (xb_ld(&bar[XB_TMO])) break; if (sp > XB_SPIN_CAP) { atomicAdd(&bar[XB_TMO], 1u); break; } }
  }
  nloc = mine > 0u ? mine : 1u; nx = cnt > 0u ? cnt : 1u;
}
DI void xcd_barrier(const XcdBarrier& b) {
  asm volatile("s_waitcnt vmcnt(0)" ::: "memory");
  __syncthreads();
  if (threadIdx.x == 0) {
    unsigned* bar = b.bar;
    __builtin_amdgcn_s_waitcnt(0);
    unsigned nloc = b.st[0], nx = b.st[1];
    if (nloc == 0u) { xcd_barrier_complete(bar, b.x, nloc, nx); b.st[0] = nloc; b.st[1] = nx; }
    const unsigned old = xb_add(&bar[XB_XSUB(b.x)], 1u);
    const unsigned gen = old / nloc;
    if (old + 1u == (gen + 1u) * nloc) {
      __builtin_amdgcn_fence(__ATOMIC_RELEASE, "agent");
      asm volatile("s_waitcnt vmcnt(0)" ::: "memory");
      const unsigned og = xb_add(&bar[XB_TOP], 1u);
      const unsigned tg = og / nx;
      if (og + 1u == (tg + 1u) * nx) xb_add(&bar[XB_TOPGEN], 1u);
      else XB_SPIN(xb_ld(&bar[XB_TOPGEN]) == tg, bar);
      __builtin_amdgcn_fence(__ATOMIC_ACQUIRE, "agent");
      xb_add(&bar[XB_XGEN(b.x)], 1u);
      asm volatile("s_waitcnt vmcnt(0)" ::: "memory");
    } else {
      XB_SPIN(xb_ld(&bar[XB_XGEN(b.x)]) == gen, bar);
      __builtin_amdgcn_fence(__ATOMIC_ACQUIRE, "agent");
      asm volatile("s_waitcnt vmcnt(0)" ::: "memory");
    }
  }
  __syncthreads();
}

constexpr int PH_PER_LAYER = 9;
constexpr int N_PHASES = 1 + 4 * PH_PER_LAYER;

DI void run_phase(const Params& p, int ph, char* smem, int rep = 0) {
  if (ph == 0) { phase0(p, smem); return; }
  const int layer = (ph - 1) / PH_PER_LAYER, sub = (ph - 1) % PH_PER_LAYER;
  const int kind = layer % 3, j = layer / 3;
  const bool last = layer == 3;
  const float* modsL = (const float*)(p.ws + OFF_MODS) + (size_t)layer * 5 * 6144;
  const bf16_t* abuf = (const bf16_t*)(p.ws + OFF_ABUF);
  char* mix = p.ws + OFF_MIX;
  switch (sub) {
    case 0:
      phase_norm(p, p.in[6] + layer * DM, modsL, 0, 1, false);
      phase_convert(p, layer);
      break;
    case 1:
      if (kind == 0) { EpiMlaIn e{(float*)(p.ws + MLA_Q)}; gemm_phase_pref<2, false>(abuf, (const bf16_t*)mix, 1024, 3, false, e, smem); }
      else if (kind == 1) { EpiHgIn e{p.ws}; gemm_phase_pref<2, false>(abuf, (const bf16_t*)mix, 1024, 20, false, e, smem); }
      else { EpiDfQkv e{p.ws, p.in[26], p.in[27]}; gemm_phase<2, true>(abuf, (const bf16_t*)mix, 1024, 12, false, e, smem); }
      break;
    case 2:
      if (kind == 0) phase_mla_post(p, j);
      else if (kind == 1) phase_hg_scan(p, smem);
      else phase_attn_df(p, !last, smem);
      break;
    case 3:
      if (kind == 0) {
        EpiMlaUq e1{p.ws, p.in[16] + j * 128, p.in[17] + j * 64};
        gemm_phase<2, true>((const bf16_t*)(p.ws + MLA_CQN), (const bf16_t*)(mix + 1572864), 384, 6, false, e1, smem);
        EpiMlaUkv e2{p.ws, p.in[18] + j * 128};
        gemm_phase<2, true>((const bf16_t*)(p.ws + MLA_CKVN), (const bf16_t*)(mix + 2752512), 256, 8, false, e2, smem);
      } else if (kind == 1) phase_hg_readout(p, j);
      break;
    case 4:
      if (kind == 0) phase_attn_mla(p, !last, smem);
      break;
    case 5: {
      EpiX e{&p, modsL + 2 * 1024, rep ? 0.f : 1.f};
      const bf16_t* wo = (const bf16_t*)(mix + (kind == 0 ? 3801088 : kind == 1 ? 10485760 : 6291456));
      gemm_phase<2, false, 8>(abuf, wo, 1024, 4, last, e, smem);
    } break;
    case 6:
      phase_norm(p, p.in[7] + layer * DM, modsL, 3, 4, last);
      break;
    case 7: {
      EpiFfnUp e{(bf16_t*)(p.ws + FFN_H)};
      gemm_phase_pref<2, false>(abuf, (const bf16_t*)(p.ws + OFF_W13), 1024, 22, last, e, smem);
    } break;
    case 8: {
      EpiX e{&p, modsL + 5 * 1024, rep ? 0.f : 1.f};
      gemm_phase<2, false, 8>((const bf16_t*)(p.ws + FFN_H), (const bf16_t*)(p.ws + OFF_W2), DFF, 4, last, e, smem);
    } break;
  }
}

DI bool phase_empty(int ph) {
  if (ph == 0) return false;
  const int layer = (ph - 1) / PH_PER_LAYER, sub = (ph - 1) % PH_PER_LAYER, kind = layer % 3;
  return (sub == 4 && kind != 0) || (sub == 3 && kind == 2);
}

__global__ void __launch_bounds__(NTHR) mega_kernel(Params p) {
  extern __shared__ __attribute__((aligned(16))) char smem[];
  cg::grid_group grid = cg::this_grid();
#if !MULTI_LAUNCH
  volatile LAS unsigned* st = (volatile LAS unsigned*)(smem + LDS_PHASE);
  if (threadIdx.x == 0) { st[0] = 0u; st[1] = 0u; st[2] = 0u; st[3] = 0u; }
  __syncthreads();
  const XcdBarrier xb = xcd_barrier_post((unsigned*)(p.ws + OFF_BAR), st);
#endif
  for (int ph = p.ph_lo; ph < p.ph_hi; ++ph) {
    if (phase_empty(ph)) continue;
#if PROBE_ON
    const int nrep = (PROBE_SEL(ph)) ? 2 : 1;
    for (int rep = 0; rep < nrep; ++rep) { run_phase(p, ph, smem, rep); if (rep + 1 < nrep) grid.sync(); }
#else
    run_phase(p, ph, smem);
#endif
    if (ph + 1 < p.ph_hi) {
#if MULTI_LAUNCH
      grid.sync();
#else
      if (ph == 0) grid.sync();
      else xcd_barrier(xb);
#endif
    }
  }
}

extern "C" void kernel_launch(void* const* d_in, const int* in_sizes, int n_in, void* d_out, int out_size, void* d_ws, size_t ws_size, hipStream_t stream) {
  static int grid_blocks = 0;
  if (grid_blocks == 0) {
    if (n_in != 31 || ws_size < WS_NEED) { fprintf(stderr, "kernel_launch: unexpected n_in %d / ws_size %zu (need %zu)\n", n_in, ws_size, (size_t)WS_NEED); grid_blocks = -1; return; }
    int dev = 0, cus = 0, per_cu = 0;
    hipGetDevice(&dev);
    hipDeviceGetAttribute(&cus, hipDeviceAttributeMultiprocessorCount, dev);
    if (hipFuncSetAttribute((const void*)mega_kernel, hipFuncAttributeMaxDynamicSharedMemorySize, LDS_BYTES) != hipSuccess) { fprintf(stderr, "hipFuncSetAttribute failed\n"); grid_blocks = -1; return; }
    if (hipOccupancyMaxActiveBlocksPerMultiprocessor(&per_cu, (const void*)mega_kernel, NTHR, LDS_BYTES) != hipSuccess || per_cu < 1) { fprintf(stderr, "occupancy query: %d\n", per_cu); per_cu = 1; }
    (void)hipGetLastError();
    grid_blocks = cus * 1;
    if (grid_blocks % 8 != 0 || grid_blocks < 8) grid_blocks = 256;
  }
  if (grid_blocks < 0) return;
  Params p{};
  for (int i = 0; i < 31; ++i) p.in[i] = (const float*)d_in[i];
  p.out = (float*)d_out; p.ws = (char*)d_ws;
#if MULTI_LAUNCH
  for (int ph = 0; ph < N_PHASES; ++ph) {
    p.ph_lo = ph; p.ph_hi = ph + 1;
    void* args[] = {&p};
    hipError_t e = hipLaunchCooperativeKernel((const void*)mega_kernel, dim3(grid_blocks), dim3(NTHR), args, LDS_BYTES, stream);
    if (e != hipSuccess) { fprintf(stderr, "launch failed: %s\n", hipGetErrorString(e)); break; }
  }
#else
  p.ph_lo = 0; p.ph_hi = N_PHASES;
  if (hipMemsetAsync((char*)d_ws + OFF_BAR, 0, XCD_BAR_WORDS * 4, stream) != hipSuccess) { fprintf(stderr, "memset of barrier words failed\n"); return; }
  void* args[] = {&p};
  hipError_t e = hipLaunchCooperativeKernel((const void*)mega_kernel, dim3(grid_blocks), dim3(NTHR), args, LDS_BYTES, stream);
  if (e != hipSuccess) fprintf(stderr, "cooperative launch failed: %s (grid %d)\n", hipGetErrorString(e), grid_blocks);
#endif
}
```
